# Optimizing an MI355X kernel written in HIP

```python
import math
import jax, jax.numpy as jnp
from jax import lax
import numpy as np

D_MODEL = 4096
BATCH = 2
SEQ = 4096
DEPTH = 1
DEC_BATCH = 8
DEC_SEQ = 32
PAST_LEN = 2048

CHUNK = 64
Q_BLOCK = 128
EPS = 1e-6
ROPE_THETA = 10000.0
MLA_HEADS = 16
MLA_NOPE_DIM = 128
MLA_ROPE_DIM = 64
MLA_V_DIM = 128
Q_LORA = 1024
KV_LORA = 512
MLA_WIDTH = MLA_HEADS * MLA_V_DIM
MLA_IN = Q_LORA + KV_LORA + MLA_ROPE_DIM
MLA_SCALE = (MLA_NOPE_DIM + MLA_ROPE_DIM) ** -0.5
SB_HEADS = 16
SB_HEAD_DIM = 128
SB_WIDTH = SB_HEADS * SB_HEAD_DIM
SB_SCALE = SB_HEAD_DIM ** -0.5
MIX_WIDTH = MLA_WIDTH + SB_WIDTH
IN_COLS = MLA_IN + 3 * SB_WIDTH
D_FF = -(-(8 * D_MODEL) // (3 * 256)) * 256
N_MOD = 6

kernel_name = "hybrid_mla_stickbreaking_streaming_step"


def rmsnorm(x, g):
    xf = x.astype(jnp.float32)
    y = xf * lax.rsqrt(jnp.mean(xf * xf, axis=-1, keepdims=True) + EPS)
    return (y * g.astype(jnp.float32)).astype(x.dtype)


def rope(x, pos):
    half = MLA_ROPE_DIM // 2
    inv = 1.0 / (ROPE_THETA ** (jnp.arange(half, dtype=jnp.float32) / half))
    ang = pos.astype(jnp.float32)[:, None] * inv[None, :]
    cos = jnp.cos(ang)[:, None, :].astype(x.dtype)
    sin = jnp.sin(ang)[:, None, :].astype(x.dtype)
    x1, x2 = x[..., :half], x[..., half:]
    return jnp.concatenate([x1 * cos - x2 * sin, x2 * cos + x1 * sin], axis=-1)


def adaln(c, w_ada, b_ada):
    mod = jax.nn.silu(c) @ w_ada + b_ada
    return jnp.split(mod[:, None, :], N_MOD, axis=-1)


def mixer_inputs(h, pos, w_in, g_q_lat, g_kv_lat, w_uq, w_uk):
    B, S, _ = h.shape
    proj = h @ w_in
    q_lat = proj[..., :Q_LORA]
    kv_lat = proj[..., Q_LORA:Q_LORA + KV_LORA]
    k_r = proj[..., Q_LORA + KV_LORA:MLA_IN]
    sb = proj[..., MLA_IN:].reshape(B, S, 3, SB_HEADS, SB_HEAD_DIM)
    q = jnp.einsum('bsr,rhe->bshe', rmsnorm(q_lat, g_q_lat), w_uq)
    q_abs = jnp.einsum('bshn,chn->bshc', q[..., :MLA_NOPE_DIM], w_uk)
    q_rope = rope(q[..., MLA_NOPE_DIM:], pos)
    latent = rmsnorm(kv_lat, g_kv_lat)
    k_rope = rope(k_r[:, :, None, :], pos)[:, :, 0, :]
    return q_abs, q_rope, latent, k_rope, sb[:, :, 0], sb[:, :, 1], sb[:, :, 2]


def mla_attend(q_abs, q_rope, q_pos, latent, k_rope, k_pos, w_uv):
    s = (jnp.einsum('bqhc,bkc->bhqk', q_abs, latent)
         + jnp.einsum('bqhr,bkr->bhqk', q_rope, k_rope)).astype(jnp.float32) * MLA_SCALE
    visible = (k_pos[None, :] // CHUNK) <= (q_pos[:, None] // CHUNK)
    p = jax.nn.softmax(jnp.where(visible, s, -jnp.inf), axis=-1).astype(latent.dtype)
    o_lat = jnp.einsum('bhqk,bkc->bqhc', p, latent)
    return jnp.einsum('bqhc,chv->bqhv', o_lat, w_uv)


def sb_attend(q, q_pos, k, v, k_pos):
    z = jnp.einsum('bqhd,bkhd->bhqk', q, k).astype(jnp.float32) * SB_SCALE
    before = k_pos[None, :] < q_pos[:, None]
    log_keep = jnp.where(before, jax.nn.log_sigmoid(-z), 0.0)
    tail = lax.cumsum(log_keep, axis=3, reverse=True) - log_keep
    log_a = jnp.where(before, jax.nn.log_sigmoid(z) + tail, -jnp.inf)
    a = jnp.exp(log_a).astype(v.dtype)
    return jnp.einsum('bhqk,bkhd->bqhd', a, v)


def to_blocks(x):
    B, S = x.shape[0], x.shape[1]
    return jnp.moveaxis(x.reshape((B, S // Q_BLOCK, Q_BLOCK) + x.shape[2:]), 1, 0)


def from_blocks(x):
    nb, B = x.shape[0], x.shape[1]
    x = jnp.moveaxis(x, 0, 1)
    return x.reshape((B, nb * Q_BLOCK) + x.shape[3:])


def trunk_layer(x, c, pos, past, w_ada, b_ada, g_mix, g_ffn, w_in, g_q_lat, g_kv_lat,
                w_uq, w_uk, w_uv, g_out_mla, g_out_sb, w_out, w_gate, w_up, w_down):
    B, S, _ = x.shape
    sh_m, sc_m, gt_m, sh_f, sc_f, gt_f = adaln(c, w_ada, b_ada)
    h = rmsnorm(x, g_mix) * (1.0 + sc_m) + sh_m
    q_abs, q_rope, lat, k_rope, sb_q, sb_k, sb_v = mixer_inputs(
        h, pos, w_in, g_q_lat, g_kv_lat, w_uq, w_uk)
    if past is None:
        def one_block(blk):
            qa, qr, sq, qp = blk
            return (mla_attend(qa, qr, qp, lat, k_rope, pos, w_uv),
                    sb_attend(sq, qp, sb_k, sb_v, pos))
        blocks = (to_blocks(q_abs), to_blocks(q_rope), to_blocks(sb_q),
                  pos.reshape(S // Q_BLOCK, Q_BLOCK))
        o_mla, o_sb = lax.map(one_block, blocks)
        o_mla, o_sb = from_blocks(o_mla), from_blocks(o_sb)
    else:
        c_lat, c_kr, c_k, c_v = past
        k_pos = jnp.arange(c_lat.shape[1] + S)
        o_mla = mla_attend(q_abs, q_rope, pos, jnp.concatenate([c_lat, lat], axis=1),
                           jnp.concatenate([c_kr, k_rope], axis=1), k_pos, w_uv)
        o_sb = sb_attend(sb_q, pos, jnp.concatenate([c_k, sb_k], axis=1),
                         jnp.concatenate([c_v, sb_v], axis=1), k_pos)
    merged = jnp.concatenate([rmsnorm(o_mla.reshape(B, S, MLA_WIDTH), g_out_mla),
                              rmsnorm(o_sb.reshape(B, S, SB_WIDTH), g_out_sb)], axis=-1)
    x = x + gt_m * (merged @ w_out)
    h = rmsnorm(x, g_ffn) * (1.0 + sc_f) + sh_f
    x = x + gt_f * ((jax.nn.silu(h @ w_gate) * (h @ w_up)) @ w_down)
    return x, (lat, k_rope, sb_k, sb_v)


def setup_inputs(seed: int = 0) -> dict:
    key = jax.random.key(seed)
    ks = jax.random.split(key, 32)
    f32 = jnp.float32
    nrm = lambda k, shape, scale: jax.random.normal(k, shape, f32) * scale
    gain = lambda k, shape: 1.0 + 0.02 * jax.random.normal(k, shape, f32)
    L = DEPTH
    return {
        "x_prompt": nrm(ks[0], (BATCH, SEQ, D_MODEL), 1.0),
        "x_sample": nrm(ks[1], (DEC_BATCH, DEC_SEQ, D_MODEL), 1.0),
        "cache_mla_latent": nrm(ks[2], (L, DEC_BATCH, PAST_LEN, KV_LORA), 1.0),
        "cache_mla_krope": nrm(ks[3], (L, DEC_BATCH, PAST_LEN, MLA_ROPE_DIM), 1.0),
        "cache_sb_k": nrm(ks[4], (L, DEC_BATCH, PAST_LEN, SB_HEADS, SB_HEAD_DIM), 1.0),
        "cache_sb_v": nrm(ks[5], (L, DEC_BATCH, PAST_LEN, SB_HEADS, SB_HEAD_DIM), 1.0),
        "c_prompt": nrm(ks[6], (BATCH, D_MODEL), 1.0),
        "c_sample": nrm(ks[7], (DEC_BATCH, D_MODEL), 1.0),
        "w_ada": nrm(ks[8], (L, D_MODEL, N_MOD * D_MODEL), 0.5 * D_MODEL ** -0.5),
        "b_ada": nrm(ks[9], (L, N_MOD * D_MODEL), 0.02),
        "g_mix": gain(ks[10], (L, D_MODEL)),
        "g_ffn": gain(ks[11], (L, D_MODEL)),
        "w_in": nrm(ks[12], (L, D_MODEL, IN_COLS), D_MODEL ** -0.5),
        "g_q_lat": gain(ks[13], (L, Q_LORA)),
        "g_kv_lat": gain(ks[14], (L, KV_LORA)),
        "w_uq": nrm(ks[15], (L, Q_LORA, MLA_HEADS, MLA_NOPE_DIM + MLA_ROPE_DIM), Q_LORA ** -0.5),
        "w_uk": nrm(ks[16], (L, KV_LORA, MLA_HEADS, MLA_NOPE_DIM), KV_LORA ** -0.5),
        "w_uv": nrm(ks[17], (L, KV_LORA, MLA_HEADS, MLA_V_DIM), KV_LORA ** -0.5),
        "g_out_mla": gain(ks[18], (L, MLA_WIDTH)),
        "g_out_sb": gain(ks[19], (L, SB_WIDTH)),
        "w_out": nrm(ks[20], (L, MIX_WIDTH, D_MODEL), MIX_WIDTH ** -0.5),
        "w_gate": nrm(ks[21], (L, D_MODEL, D_FF), D_MODEL ** -0.5),
        "w_up": nrm(ks[22], (L, D_MODEL, D_FF), D_MODEL ** -0.5),
        "w_down": nrm(ks[23], (L, D_FF, D_MODEL), D_FF ** -0.5),
        "g_final": gain(ks[24], (D_MODEL,)),
    }


def reference(x_prompt, x_sample, cache_mla_latent, cache_mla_krope, cache_sb_k, cache_sb_v,
              c_prompt, c_sample, w_ada, b_ada, g_mix, g_ffn, w_in, g_q_lat, g_kv_lat,
              w_uq, w_uk, w_uv, g_out_mla, g_out_sb, w_out, w_gate, w_up, w_down, g_final):
    pos_p = jnp.arange(x_prompt.shape[1])
    pos_s = cache_mla_latent.shape[2] + jnp.arange(x_sample.shape[1])
    xp, xs = x_prompt, x_sample
    new_p, new_s = [], []
    for l in range(DEPTH):
        w = (w_ada[l], b_ada[l], g_mix[l], g_ffn[l], w_in[l], g_q_lat[l], g_kv_lat[l],
             w_uq[l], w_uk[l], w_uv[l], g_out_mla[l], g_out_sb[l], w_out[l],
             w_gate[l], w_up[l], w_down[l])
        xp, st_p = trunk_layer(xp, c_prompt, pos_p, None, *w)
        past = (cache_mla_latent[l], cache_mla_krope[l], cache_sb_k[l], cache_sb_v[l])
        xs, st_s = trunk_layer(xs, c_sample, pos_s, past, *w)
        new_p.append(st_p)
        new_s.append(st_s)
    y_prompt = rmsnorm(xp, g_final)
    y_sample = rmsnorm(xs, g_final)
    p_lat = jnp.stack([s[0] for s in new_p], axis=0)
    p_krope = jnp.stack([s[1] for s in new_p], axis=0)
    p_sbk = jnp.stack([s[2] for s in new_p], axis=0)
    p_sbv = jnp.stack([s[3] for s in new_p], axis=0)
    s_lat = jnp.stack([s[0] for s in new_s], axis=0)
    s_krope = jnp.stack([s[1] for s in new_s], axis=0)
    s_sbk = jnp.stack([s[2] for s in new_s], axis=0)
    s_sbv = jnp.stack([s[3] for s in new_s], axis=0)
    return (y_prompt, y_sample, p_lat, p_krope, p_sbk, p_sbv, s_lat, s_krope, s_sbk, s_sbv)
```

```cpp
#include <hip/hip_runtime.h>
#include <cstdio>
#include <cstdint>

#ifndef PROBE_DUP
#define PROBE_DUP -1
#endif
#ifndef MK_ONE_LAUNCH
#define MK_ONE_LAUNCH 1
#endif

constexpr int DM = 4096, SEQ = 4096, NB_P = 2, NB_S = 8, DSEQ = 32, PAST = 2048;
constexpr int MP = NB_P * SEQ;
constexpr int MS = NB_S * DSEQ;
constexpr int MT = MP + MS;
constexpr int MC = NB_S * PAST;
constexpr int ML = MT + MC;
constexpr int NH = 16, QLORA = 1024, KVLORA = 512, ROPE = 64, NOPE = 128, VD = 128, SBD = 128;
constexpr int INCOLS = 7744, N1 = 7936;
constexpr int DFF = 11008, NGU = 2 * DFF;
constexpr int NMOD = 6 * DM;
constexpr float EPS = 1e-6f;
constexpr int XPITCH = DM;
constexpr float LOG2E = 1.4426950408889634f;
constexpr float MLA_QS = 0.07216878364870322f * LOG2E;
constexpr float SB_QS = 0.08838834764831845f * LOG2E;
constexpr int GU_NF8 = 4;
constexpr int GU_KB16 = DM - 128 * GU_NF8, GU_NT16 = GU_KB16 / 64, GU_NT = GU_NT16 + GU_NF8;
constexpr float H8_SCALE = 8.0f, WGU_SCALE = 2048.0f;
constexpr float ACT_SCALE = 8.0f, WD_SCALE = 2048.0f;

constexpr size_t OUT_Y = 0, OUT_PLAT = 34603008, OUT_PKR = 38797312, OUT_PSBK = 39321600, OUT_PSBV = 56098816,
                 OUT_SLAT = 72876032, OUT_SKR = 73007104, OUT_SSBK = 73023488, OUT_SSBV = 73547776, OUT_TOTAL = 74072064;

constexpr size_t MiB = 1u << 20;
constexpr size_t WS_CTL = 0, CTL_ZERO_BYTES = 1 * MiB;
constexpr size_t WS_MOD = 1 * MiB;
constexpr size_t WS_COS = 2 * MiB, WS_SIN = 3 * MiB;
constexpr size_t WS_QSS = 4 * MiB;
constexpr size_t WS_KVSS = 5 * MiB;
constexpr size_t WS_OSS = 6 * MiB;
constexpr size_t WS_W1T = 8 * MiB;
constexpr size_t WS_WUQT = 72 * MiB;
constexpr size_t WS_WUKVT = 80 * MiB;
constexpr size_t WS_WOUTT = 84 * MiB;
constexpr size_t WS_WGUT = 116 * MiB;
constexpr size_t WS_WDT = 288 * MiB;
constexpr size_t WS_H = 376 * MiB;
constexpr size_t WS_A2A = 444 * MiB;
constexpr size_t WS_LATA = 462 * MiB;
constexpr size_t WS_KR = 488 * MiB;
constexpr size_t WS_KV = 492 * MiB;
constexpr size_t WS_QM = 688 * MiB;
constexpr size_t WS_SBQ = 738 * MiB, WS_SBK = 772 * MiB, WS_SBV = 806 * MiB;
constexpr size_t WS_O = 840 * MiB;
constexpr size_t WS_X1 = 908 * MiB;
constexpr size_t WS_X2 = 975 * MiB;
constexpr size_t WS_ACT = 1042 * MiB;
constexpr size_t WS_SLAB = 1222 * MiB;
constexpr size_t WS_ADAP = 1288 * MiB;
constexpr size_t WS_END = 1320 * MiB;
constexpr int CW_BAR = 4096;
constexpr int CW_QUEUE = 64;

#define GAS __attribute__((address_space(1)))
#define LAS __attribute__((address_space(3)))
typedef unsigned short bf16;
typedef unsigned v4u __attribute__((ext_vector_type(4)));
typedef unsigned v2u __attribute__((ext_vector_type(2)));
typedef float f32x4 __attribute__((ext_vector_type(4)));
typedef float f32x2 __attribute__((ext_vector_type(2)));
typedef float f32x16 __attribute__((ext_vector_type(16)));
typedef short bf16x8 __attribute__((ext_vector_type(8)));
typedef short s16x4 __attribute__((ext_vector_type(4)));
typedef __bf16 bf16x2_t __attribute__((ext_vector_type(2)));
#define LDS_WAIT() asm volatile("s_waitcnt lgkmcnt(0)" ::: "memory")
__device__ __forceinline__ unsigned pk2(float lo, float hi) { f32x2 v = {lo, hi}; bf16x2_t b = __builtin_convertvector(v, bf16x2_t); return __builtin_bit_cast(unsigned, b); }
__device__ __forceinline__ v2u pk4(f32x4 v) { v2u r; r.x = pk2(v[0], v[1]); r.y = pk2(v[2], v[3]); return r; }
__device__ __forceinline__ f32x4 up4(v2u w) { f32x4 r; r[0] = __uint_as_float(w.x << 16); r[1] = __uint_as_float(w.x & 0xffff0000u); r[2] = __uint_as_float(w.y << 16); r[3] = __uint_as_float(w.y & 0xffff0000u); return r; }
typedef _Float16 h16x4 __attribute__((ext_vector_type(4)));
__device__ __forceinline__ v2u pk4h(f32x4 v) { const h16x4 h = __builtin_convertvector(v, h16x4); return __builtin_bit_cast(v2u, h); }
__device__ __forceinline__ f32x4 up4h(v2u w) { const h16x4 h = __builtin_bit_cast(h16x4, w); return __builtin_convertvector(h, f32x4); }
__device__ __forceinline__ void up8h(v4u w, f32x4& a, f32x4& b) { v2u lo; lo.x = w.x; lo.y = w.y; v2u hi; hi.x = w.z; hi.y = w.w; a = up4h(lo); b = up4h(hi); }
__device__ __forceinline__ v4u pk8(f32x4 a, f32x4 b) { const v2u x = pk4(a), y = pk4(b); v4u o; o.x = x.x; o.y = x.y; o.z = y.x; o.w = y.y; return o; }
__device__ __forceinline__ unsigned pk4f8(f32x4 a, float sc) {
    const float r0 = __builtin_amdgcn_fmed3f(a[0] * sc, -448.0f, 448.0f), r1 = __builtin_amdgcn_fmed3f(a[1] * sc, -448.0f, 448.0f), r2 = __builtin_amdgcn_fmed3f(a[2] * sc, -448.0f, 448.0f), r3 = __builtin_amdgcn_fmed3f(a[3] * sc, -448.0f, 448.0f);
    int p = __builtin_amdgcn_cvt_pk_fp8_f32(r0, r1, 0, false); p = __builtin_amdgcn_cvt_pk_fp8_f32(r2, r3, p, true); return (unsigned)p; }
__device__ __forceinline__ float wave_sum(float v) {
#pragma unroll
    for (int o = 1; o < 64; o <<= 1) v += __shfl_xor(v, o);
    return v;
}
__device__ __forceinline__ int bidx_of(int row) { return row < MP ? (row >> 12) : 2 + ((row - MP) >> 5); }
__device__ __forceinline__ int pos_of(int row) { return row < MP ? (row & (SEQ - 1)) : PAST + ((row - MP) & 31); }

#define XB_TMO      128
#define XB_XCNT(j)  (256  + 64 * (j))
#define XB_XSUB(j)  (1280 + 64 * (j))
#define XB_XGEN(j)  (2304 + 64 * (j))
#define XB_TOP      3328
#define XB_TOPGEN   3392
#define XCD_BAR_WORDS 3456
#define XB_SPIN_CAP (1u << 18)
__device__ __forceinline__ unsigned xb_ld(unsigned* p)              { return __hip_atomic_load(p, __ATOMIC_RELAXED, __HIP_MEMORY_SCOPE_AGENT); }
__device__ __forceinline__ unsigned xb_add(unsigned* p, unsigned v) { return __hip_atomic_fetch_add(p, v, __ATOMIC_RELAXED, __HIP_MEMORY_SCOPE_AGENT); }
__device__ __forceinline__ unsigned xb_xcc_id() { return (unsigned)__builtin_amdgcn_s_getreg((3 << 11) | 20) & 0xFu; }
#define XB_SPIN(cond, bar) do { unsigned _sp = 0; while (cond) { __builtin_amdgcn_s_sleep(1); \
    if ((++_sp & 255u) == 0u) { if (xb_ld(&(bar)[XB_TMO])) break; if (_sp > XB_SPIN_CAP) { atomicAdd(&(bar)[XB_TMO], 1u); break; } } } } while (0)
struct XcdBarrier { unsigned* bar; unsigned x; volatile LAS unsigned* st; };
__device__ __forceinline__ XcdBarrier xcd_barrier_post(unsigned* bar, volatile LAS unsigned* st) {
    XcdBarrier b; b.bar = bar; b.x = xb_xcc_id(); b.st = st;
    if (threadIdx.x == 0) (void)xb_add(&bar[XB_XCNT(b.x)], 1u);
    return b;
}
__device__ __forceinline__ void xcd_barrier_complete(unsigned* bar, unsigned x, unsigned& nloc, unsigned& nx) {
    const unsigned G = gridDim.x * gridDim.y * gridDim.z;
    unsigned sum, cnt, mine, sp = 0u;
    for (;;) {
        sum = 0u; cnt = 0u; mine = 0u;
#pragma unroll
        for (unsigned j = 0; j < 16; ++j) { const unsigned c = xb_ld(&bar[XB_XCNT(j)]); sum += c; cnt += (c > 0u) ? 1u : 0u; mine = (j == x) ? c : mine; }
        if (sum == G) break;
        __builtin_amdgcn_s_sleep(1);
        if ((++sp & 255u) == 0u) { if (xb_ld(&bar[XB_TMO])) break; if (sp > XB_SPIN_CAP) { atomicAdd(&bar[XB_TMO], 1u); break; } }
    }
    nloc = mine > 0u ? mine : 1u; nx = cnt > 0u ? cnt : 1u;
}
__device__ __forceinline__ void xcd_barrier(const XcdBarrier& b) {
    asm volatile("s_waitcnt vmcnt(0)" ::: "memory");
    __syncthreads();
    if (threadIdx.x == 0) {
        unsigned* bar = b.bar;
        __builtin_amdgcn_s_waitcnt(0);
        unsigned nloc = b.st[0], nx = b.st[1];
        if (nloc == 0u) { xcd_barrier_complete(bar, b.x, nloc, nx); b.st[0] = nloc; b.st[1] = nx; }
        const unsigned old = xb_add(&bar[XB_XSUB(b.x)], 1u);
        const unsigned gen = old / nloc;
        if (old + 1u == (gen + 1u) * nloc) {
            __builtin_amdgcn_fence(__ATOMIC_RELEASE, "agent");
            asm volatile("s_waitcnt vmcnt(0)" ::: "memory");
            const unsigned og = xb_add(&bar[XB_TOP], 1u);
            const unsigned tg = og / nx;
            if (og + 1u == (tg + 1u) * nx) xb_add(&bar[XB_TOPGEN], 1u);
            else XB_SPIN(xb_ld(&bar[XB_TOPGEN]) == tg, bar);
            __builtin_amdgcn_fence(__ATOMIC_ACQUIRE, "agent");
            xb_add(&bar[XB_XGEN(b.x)], 1u);
            asm volatile("s_waitcnt vmcnt(0)" ::: "memory");
        } else {
            XB_SPIN(xb_ld(&bar[XB_XGEN(b.x)]) == gen, bar);
            __builtin_amdgcn_fence(__ATOMIC_ACQUIRE, "agent");
            asm volatile("s_waitcnt vmcnt(0)" ::: "memory");
        }
    }
    __syncthreads();
}

namespace pg8 {
#define PG8_LAS __attribute__((address_space(3)))
typedef unsigned short bf16_t;
typedef int v4i_t __attribute__((ext_vector_type(4)));
typedef int v8i_t __attribute__((ext_vector_type(8)));
constexpr int BM = 256, BK = 64, HALF = 128, HTB = HALF * BK * 2, STAGE_BYTES = 8 * HTB, NXCD = 8, WGM = 8;
__host__ __device__ __forceinline__ int lds_byte(int r, int c) { const int st = (r >> 4) * 2 + (c >> 5), rr = r & 15, cc = c & 31, ob = rr * 64 + cc * 2; return st * 1024 + (ob ^ (((ob >> 9) & 1) << 5)); }
__host__ __device__ __forceinline__ void stage_rc(int b, int& R, int& C) { const int st = b / 1024, sb = b % 1024, swz = sb ^ (((sb >> 9) & 1) << 5); R = (st >> 1) * 16 + swz / 64; C = (st & 1) * 32 + (swz % 64) / 2; }
__host__ __device__ __forceinline__ int perm32(int rho) { const int n = rho >> 4, i = rho & 15; return 8 * (i >> 2) + 4 * n + (i & 3); }
template <bool B> struct BoolTag { static constexpr bool value = B; };
struct Unit { int pm, pn, kt0, nt, split; };
struct Gemm { const bf16_t* A; const bf16_t* Bt; int M, N, K; };
struct StaticOrder {
    int nM, nN, nwg, G, c, ntf;
    __host__ __device__ void init(int M, int N, int G_, int c_, int K_) { nM = M / BM; nN = N / BM; nwg = nM * nN; G = G_; c = c_; ntf = K_ / BK; }
    __host__ __device__ __forceinline__ void tile_of(int L, int& pm, int& pn) const {
        int wgid = L; { const int q = nwg / NXCD, r = nwg % NXCD, xcd = wgid % NXCD, off = wgid / NXCD; wgid = (xcd < r ? xcd * (q + 1) : r * (q + 1) + (xcd - r) * q) + off; }
        const int nig = WGM * nN, gid = wgid / nig, fm = gid * WGM, gsz = (nM - fm) < WGM ? (nM - fm) : WGM;
        pm = fm + ((wgid % nig) % gsz); pn = (wgid % nig) / gsz;
    }
    __host__ __device__ __forceinline__ bool next(int i, Unit& u) const {
        const long L = (long)i * G + c; if (L >= nwg) return false;
        tile_of((int)L, u.pm, u.pn); u.kt0 = 0; u.nt = ntf; u.split = -1; return true;
    }
    __device__ __forceinline__ void a_ready(const Unit&) const {}
    __device__ __forceinline__ void done(const Unit&) const {}
};
struct TailSplitOrder {
    StaticOrder so; int pmS;
    __host__ __device__ void init(int M, int N, int G_, int c_, int K_, int pmS_) { so.init(M, N, G_, c_, K_); pmS = pmS_; }
    __host__ __device__ __forceinline__ bool next(int i, Unit& u) const {
        Unit a; a.pm = 0; a.pn = 0; a.kt0 = 0; a.nt = so.ntf; a.split = -1;
        const bool fa = so.next(i, a);
        const long L = (long)i * so.G + so.c - so.nwg; const bool fb = !fa && L >= 0 && L < 256;
        const int sp = (int)(L & 15), small = 2 * (so.ntf / 32), nb = (so.ntf - 16 * small) / 2;
        const int nt2 = sp < nb ? small + 2 : small, kt2 = sp < nb ? sp * (small + 2) : nb * (small + 2) + (sp - nb) * small;
        u.pm = fa ? a.pm : pmS; u.pn = fa ? a.pn : (int)(L >> 4); u.kt0 = fa ? 0 : kt2; u.nt = fa ? so.ntf : nt2; u.split = fa ? -1 : sp;
        return fa || fb;
    }
    __device__ __forceinline__ void a_ready(const Unit&) const {}
    __device__ __forceinline__ void done(const Unit&) const {}
};
template <class Epi, class Sched, bool ALIGN_EPI = false, bool SP2 = false>
__device__ __forceinline__ void gemm_phase(PG8_LAS unsigned char* lds, const Gemm g, const Sched& S, const Epi& E) {
    const int tid = threadIdx.x, wid = __builtin_amdgcn_readfirstlane(tid >> 6), lane = tid & 63, wr = wid >> 2, wc = wid & 3, fr = lane & 15, fq = lane >> 4;
    const int K = g.K;
    unsigned voffA[2], voffB[2];
#pragma unroll
    for (int i = 0; i < 2; ++i) { int R, C; stage_rc(tid * 16 + i * 8192, R, C); const int Rb = Epi::PERM ? ((R & ~31) + perm32(R & 31)) : R;
        voffA[i] = (unsigned)(R * K + C) * 2u; voffB[i] = (unsigned)(Rb * K + C) * 2u; }
    const size_t kstep = (size_t)(BK * 2);
    const size_t hstep = (size_t)HALF * K * 2;
    const size_t tstep = 2 * hstep;
    const unsigned ldsw = (unsigned)wid * 1024u;
    const int aoff = lds_byte(wr * 64 + fr, fq * 8), boff = lds_byte(wc * 32 + fr, fq * 8);
#define PG8_SA(b, h) (((b) * 2 + (h)) * HTB)
#define PG8_SB(b, h) ((4 + (b) * 2 + (h)) * HTB)
#define PG8_STAGE(bufoff, gbase, voff) do { _Pragma("unroll") for (int _i = 0; _i < 2; ++_i) \
        __builtin_amdgcn_global_load_lds((const unsigned*)((const char*)(gbase) + (voff)[_i]), (PG8_LAS unsigned*)(lds + (bufoff) + ldsw + _i * 8192), 16, 0, 0); } while (0)
#define PG8_LDA(dst, b, h) do { if constexpr (F8) { _Pragma("unroll") for (int m = 0; m < 4; ++m) dst##8[m] = PG8_CAT8(*(const PG8_LAS bf16x8*)(lds + PG8_SA(b, h) + aoff + m * 2048), *(const PG8_LAS bf16x8*)(lds + PG8_SA(b, h) + aoff + m * 2048 + 1024)); } \
        else { _Pragma("unroll") for (int m = 0; m < 4; ++m) _Pragma("unroll") for (int k = 0; k < 2; ++k) dst[m][k] = *(const PG8_LAS bf16x8*)(lds + PG8_SA(b, h) + aoff + m * 2048 + k * 1024); } } while (0)
#define PG8_LDB(dst, b, h) do { if constexpr (F8) { _Pragma("unroll") for (int n = 0; n < 2; ++n) dst##8[n] = PG8_CAT8(*(const PG8_LAS bf16x8*)(lds + PG8_SB(b, h) + boff + n * 2048), *(const PG8_LAS bf16x8*)(lds + PG8_SB(b, h) + boff + n * 2048 + 1024)); } \
        else { _Pragma("unroll") for (int n = 0; n < 2; ++n) _Pragma("unroll") for (int k = 0; k < 2; ++k) dst[n][k] = *(const PG8_LAS bf16x8*)(lds + PG8_SB(b, h) + boff + n * 2048 + k * 1024); } } while (0)
#define PG8_CAT8(x, y) __builtin_shufflevector(__builtin_bit_cast(v4i_t, (x)), __builtin_bit_cast(v4i_t, (y)), 0, 1, 2, 3, 4, 5, 6, 7)
#define PG8_MMA(ai, bj, At, Bt) do { __builtin_amdgcn_s_setprio(1); \
        if constexpr (F8) { _Pragma("unroll") for (int m = 0; m < 4; ++m) _Pragma("unroll") for (int n = 0; n < 2; ++n) \
            asm volatile("v_mfma_f32_16x16x128_f8f6f4 %0, %1, %2, %0" : "+v"(acc[ai][bj][m][n]) : "v"(Bt##8[n]), "v"(At##8[m])); }     \
        else { _Pragma("unroll") for (int m = 0; m < 4; ++m) _Pragma("unroll") for (int n = 0; n < 2; ++n) _Pragma("unroll") for (int k = 0; k < 2; ++k) \
            acc[ai][bj][m][n] = __builtin_amdgcn_mfma_f32_16x16x32_bf16(Bt[n][k], At[m][k], acc[ai][bj][m][n], 0, 0, 0); } \
        __builtin_amdgcn_s_setprio(0); } while (0)
#define PG8_WAIT_V(n) asm volatile("s_waitcnt vmcnt(" #n ")" ::: "memory")
#define PG8_WAIT_L(n) asm volatile("s_waitcnt lgkmcnt(" #n ")" ::: "memory")
#define PG8_BAR __builtin_amdgcn_s_barrier()
#define PG8_SCHED __builtin_amdgcn_sched_barrier(0)
    Unit cur, nxt; int ui = 0;
    if (!S.next(0, cur)) return;
    f32x4 acc[2][2][4][2];
#pragma unroll
    for (int a = 0; a < 2; ++a)
#pragma unroll
        for (int b = 0; b < 2; ++b)
#pragma unroll
            for (int m = 0; m < 4; ++m)
#pragma unroll
                for (int n = 0; n < 2; ++n) acc[a][b][m][n] = (f32x4){0.f, 0.f, 0.f, 0.f};
    bf16x8 At[4][2], B0[2][2], B1[2][2]; v8i_t At8[4], B08[2], B18[2];
    const char* cA = (const char*)g.A + (size_t)cur.pm * tstep + (size_t)cur.kt0 * kstep; const char* cB = (const char*)g.Bt + (size_t)cur.pn * tstep + (size_t)cur.kt0 * kstep;
    S.a_ready(cur);
    if constexpr (SP2) {
        PG8_STAGE(PG8_SB(0, 0), cB, voffB); PG8_STAGE(PG8_SB(0, 1), cB + hstep, voffB); PG8_STAGE(PG8_SA(0, 0), cA, voffA); PG8_STAGE(PG8_SA(0, 1), cA + hstep, voffA);
        if (wr == 1) PG8_BAR;
        PG8_WAIT_V(2); PG8_BAR;
        PG8_STAGE(PG8_SB(1, 0), cB + kstep, voffB); PG8_STAGE(PG8_SA(1, 0), cA + kstep, voffA); PG8_STAGE(PG8_SB(1, 1), cB + hstep + kstep, voffB);
        PG8_WAIT_V(6); PG8_BAR;
    } else {
        PG8_STAGE(PG8_SB(0, 0), cB, voffB); PG8_STAGE(PG8_SA(0, 0), cA, voffA); PG8_STAGE(PG8_SB(0, 1), cB + hstep, voffB); PG8_STAGE(PG8_SA(0, 1), cA + hstep, voffA);
        if (wr == 1) PG8_BAR;
        PG8_WAIT_V(4); PG8_BAR;
        PG8_STAGE(PG8_SB(1, 0), cB + kstep, voffB); PG8_STAGE(PG8_SA(1, 0), cA + kstep, voffA); PG8_STAGE(PG8_SB(1, 1), cB + hstep + kstep, voffB);
        PG8_WAIT_V(6); PG8_BAR;
    }
    for (;;) {
        const bool has_next = S.next(ui + 1, nxt);
        const char* nA = has_next ? (const char*)g.A + (size_t)nxt.pm * tstep + (size_t)nxt.kt0 * kstep : cA; const char* nB = has_next ? (const char*)g.Bt + (size_t)nxt.pn * tstep + (size_t)nxt.kt0 * kstep : cB;
        const int nt = cur.nt;
        auto kloop = [&](auto f8tag, const int t0, const int t1) __attribute__((always_inline)) {
        constexpr bool F8 = decltype(f8tag)::value;
        for (int t = t0; t < t1; t += 2) {
            const bool last = (t == nt - 2);
            const char* a1 = cA + (size_t)(t + 1) * kstep;
            const char* a2 = last ? nA : cA + (size_t)(t + 2) * kstep; const char* b2 = last ? nB : cB + (size_t)(t + 2) * kstep;
            const char* a3 = a2 + kstep; const char* b3 = b2 + kstep;
            if (last && has_next) S.a_ready(nxt);
            if constexpr (SP2) {
            PG8_LDB(B0, 0, 0); PG8_LDB(B1, 0, 1); PG8_SCHED; PG8_LDA(At, 0, 0); PG8_STAGE(PG8_SA(1, 1), a1 + hstep, voffA);
            PG8_WAIT_V(8); PG8_WAIT_L(0); PG8_BAR; PG8_MMA(0, 0, At, B0); PG8_MMA(0, 1, At, B1); PG8_BAR; PG8_SCHED;
            PG8_LDA(At, 0, 1); PG8_STAGE(PG8_SB(0, 0), b2, voffB); PG8_STAGE(PG8_SB(0, 1), b2 + hstep, voffB); PG8_STAGE(PG8_SA(0, 0), a2, voffA);
            PG8_WAIT_V(8); PG8_WAIT_L(0); PG8_BAR; PG8_MMA(1, 0, At, B0); PG8_MMA(1, 1, At, B1); PG8_BAR; PG8_SCHED;
            PG8_LDB(B0, 1, 0); PG8_LDB(B1, 1, 1); PG8_SCHED; PG8_LDA(At, 1, 0); PG8_STAGE(PG8_SA(0, 1), a2 + hstep, voffA);
            PG8_WAIT_V(8); PG8_WAIT_L(0); PG8_BAR; PG8_MMA(0, 0, At, B0); PG8_MMA(0, 1, At, B1); PG8_BAR; PG8_SCHED;
            PG8_LDA(At, 1, 1); PG8_STAGE(PG8_SB(1, 0), b3, voffB); PG8_STAGE(PG8_SB(1, 1), b3 + hstep, voffB); PG8_STAGE(PG8_SA(1, 0), a3, voffA);
            PG8_WAIT_V(8); PG8_WAIT_L(0); PG8_BAR; PG8_MMA(1, 0, At, B0); PG8_MMA(1, 1, At, B1); PG8_BAR; PG8_SCHED;
            } else {
            PG8_LDB(B0, 0, 0); PG8_SCHED; PG8_LDA(At, 0, 0); PG8_STAGE(PG8_SA(1, 1), a1 + hstep, voffA);
            PG8_WAIT_L(8); PG8_BAR; PG8_WAIT_L(0); PG8_MMA(0, 0, At, B0); PG8_BAR; PG8_SCHED;
            PG8_LDB(B1, 0, 1); PG8_STAGE(PG8_SB(0, 0), b2, voffB);
            PG8_BAR; PG8_WAIT_L(0); PG8_MMA(0, 1, At, B1); PG8_BAR;
            PG8_LDA(At, 0, 1); PG8_STAGE(PG8_SA(0, 0), a2, voffA);
            PG8_BAR; PG8_WAIT_L(0); PG8_MMA(1, 0, At, B0); PG8_BAR; PG8_SCHED;
            PG8_STAGE(PG8_SB(0, 1), b2 + hstep, voffB);
            PG8_WAIT_V(6); PG8_BAR; PG8_MMA(1, 1, At, B1); PG8_BAR;
            PG8_LDB(B0, 1, 0); PG8_SCHED; PG8_LDA(At, 1, 0); PG8_STAGE(PG8_SA(0, 1), a2 + hstep, voffA);
            PG8_WAIT_L(8); PG8_BAR; PG8_WAIT_L(0); PG8_MMA(0, 0, At, B0); PG8_BAR; PG8_SCHED;
            PG8_LDB(B1, 1, 1); PG8_STAGE(PG8_SB(1, 0), b3, voffB);
            PG8_BAR; PG8_WAIT_L(0); PG8_MMA(0, 1, At, B1); PG8_BAR;
            PG8_LDA(At, 1, 1); PG8_STAGE(PG8_SA(1, 0), a3, voffA);
            PG8_BAR; PG8_WAIT_L(0); PG8_MMA(1, 0, At, B0); PG8_BAR; PG8_SCHED;
            PG8_STAGE(PG8_SB(1, 1), b3 + hstep, voffB);
            PG8_WAIT_V(6); PG8_BAR; PG8_MMA(1, 1, At, B1); PG8_BAR;
            }
        } };
        if constexpr (Epi::MIXNT16 > 0) {
            kloop(BoolTag<false>{}, 0, Epi::MIXNT16);
#pragma unroll
            for (int a = 0; a < 2; ++a)
#pragma unroll
                for (int b = 0; b < 2; ++b)
#pragma unroll
                    for (int m = 0; m < 4; ++m)
#pragma unroll
                        for (int n = 0; n < 2; ++n) acc[a][b][m][n] *= Epi::MIXSCALE;
            PG8_SCHED;
            kloop(BoolTag<true>{}, Epi::MIXNT16, nt);
        } else kloop(BoolTag<Epi::FP8>{}, 0, nt);
        if constexpr (Epi::FP8 || Epi::MIXNT16 > 0) asm volatile("s_nop 15\n\ts_nop 15" ::: "memory");
        if constexpr (ALIGN_EPI) { if (wr == 0) PG8_BAR; }
        E(acc, cur, wr, wc, fr, fq); S.done(cur);
        if (!has_next) break;
#pragma unroll
        for (int a = 0; a < 2; ++a)
#pragma unroll
            for (int b = 0; b < 2; ++b)
#pragma unroll
                for (int m = 0; m < 4; ++m)
#pragma unroll
                    for (int n = 0; n < 2; ++n) acc[a][b][m][n] = (f32x4){0.f, 0.f, 0.f, 0.f};
        cur = nxt; cA = nA; cB = nB; ++ui;
        if constexpr (ALIGN_EPI) { if (wr == 1) PG8_BAR; }
    }
    PG8_WAIT_V(0);
    if constexpr (!ALIGN_EPI) { if (wr == 0) PG8_BAR; }
    PG8_BAR;
#undef PG8_SA
#undef PG8_SB
#undef PG8_STAGE
#undef PG8_LDA
#undef PG8_LDB
#undef PG8_MMA
#undef PG8_CAT8
#undef PG8_WAIT_V
#undef PG8_WAIT_L
#undef PG8_BAR
#undef PG8_SCHED
}
}
#define PG8_SP2 true
#define PG8_ALIGN true

constexpr int NWAVES = 8;
constexpr int RING_OFF = 0, RING_BYTES = 131072;
constexpr int LDSCTL_OFF = RING_BYTES, MISC_OFF = LDSCTL_OFF + 320;
constexpr int LDS_BYTES = 147456;

struct Args { const float* in[25]; float* out; unsigned char* ws; int ph_lo, ph_hi; };

struct Frame {
    LAS unsigned char* lds;
    volatile LAS unsigned* MISC;
    unsigned* ctl;
    int tid, lane, wave, G, gw, NGW;
    float* out; unsigned char* ws;
};
#define WSP(T, off) ((T*)(F.ws + (off)))

struct Epi1 {
    static constexpr bool FP8 = false; static constexpr int MIXNT16 = 0;
    static constexpr bool PERM = false;
    const float *g_q, *g_kv; unsigned char* ws; float* out;
    __device__ __forceinline__ void operator()(const f32x4 (&acc)[2][2][4][2], const pg8::Unit& u, int wr, int wc, int fr, int fq) const {
        const int pn = u.pn; const bool samp = (u.pm >= MP / 256);
        const int row0 = u.pm * 256 + wr * 64 + fr;
        const int cw = wc * 32 + 4 * fq;
        if (pn < 4) {
            bf16* A2A = (bf16*)(ws + WS_A2A); float* QSS = (float*)(ws + WS_QSS);
            f32x4 gv[2][2];
#pragma unroll
            for (int bj = 0; bj < 2; ++bj)
#pragma unroll
                for (int n = 0; n < 2; ++n) gv[bj][n] = *(const f32x4*)(g_q + pn * 256 + bj * 128 + n * 16 + cw);
#pragma unroll
            for (int ai = 0; ai < 2; ++ai)
#pragma unroll
                for (int m = 0; m < 4; ++m) {
                    const int row = row0 + ai * 128 + m * 16; float ss = 0.f;
#pragma unroll
                    for (int bj = 0; bj < 2; ++bj)
#pragma unroll
                        for (int n = 0; n < 2; ++n) { const f32x4 v = acc[ai][bj][m][n]; ss += (v[0] * v[0] + v[1] * v[1]) + (v[2] * v[2] + v[3] * v[3]);
                            *(v2u*)(A2A + (size_t)row * QLORA + pn * 256 + bj * 128 + n * 16 + cw) = pk4(v * gv[bj][n]); }
                    ss += __shfl_xor(ss, 16); ss += __shfl_xor(ss, 32);
                    if (fq == 0) QSS[row * 16 + pn * 4 + wc] = ss;
                }
        } else if (pn < 6) {
            bf16* LATA = (bf16*)(ws + WS_LATA); float* KVSS = (float*)(ws + WS_KVSS);
            const int ct = (pn - 4) * 256;
            f32x4 gv[2][2];
#pragma unroll
            for (int bj = 0; bj < 2; ++bj)
#pragma unroll
                for (int n = 0; n < 2; ++n) gv[bj][n] = *(const f32x4*)(g_kv + ct + bj * 128 + n * 16 + cw);
            float* of = out + (samp ? OUT_SLAT - (size_t)MP * KVLORA : OUT_PLAT);
#pragma unroll
            for (int ai = 0; ai < 2; ++ai)
#pragma unroll
                for (int m = 0; m < 4; ++m) {
                    const int row = row0 + ai * 128 + m * 16; float ss = 0.f;
#pragma unroll
                    for (int bj = 0; bj < 2; ++bj)
#pragma unroll
                        for (int n = 0; n < 2; ++n) { const f32x4 v = acc[ai][bj][m][n]; ss += (v[0] * v[0] + v[1] * v[1]) + (v[2] * v[2] + v[3] * v[3]);
                            const int col = ct + bj * 128 + n * 16 + cw;
                            *(f32x4*)(of + (size_t)row * KVLORA + col) = v;
                            *(v2u*)(LATA + (size_t)row * KVLORA + col) = pk4(v * gv[bj][n]); }
                    ss += __shfl_xor(ss, 16); ss += __shfl_xor(ss, 32);
                    if (fq == 0) KVSS[row * 8 + (pn - 4) * 4 + wc] = ss;
                }
        } else if (pn < 14) {
            bf16* SBQ = (bf16*)(ws + WS_SBQ);
            const int ct = (pn - 6) * 256;
#pragma unroll
            for (int ai = 0; ai < 2; ++ai)
#pragma unroll
                for (int m = 0; m < 4; ++m) {
                    const int row = row0 + ai * 128 + m * 16;
#pragma unroll
                    for (int bj = 0; bj < 2; ++bj)
#pragma unroll
                        for (int n = 0; n < 2; ++n) *(v2u*)(SBQ + (size_t)row * 2048 + ct + bj * 128 + n * 16 + cw) = pk4(acc[ai][bj][m][n] * SB_QS);
                }
        } else if (pn < 30) {
            const bool isk = pn < 22; const int ct = (pn - (isk ? 14 : 22)) * 256;
            bf16* ob = (bf16*)(ws + (isk ? WS_SBK : WS_SBV));
            float* of = out + (samp ? (isk ? OUT_SSBK : OUT_SSBV) - (size_t)MP * 2048 : (isk ? OUT_PSBK : OUT_PSBV));
#pragma unroll
            for (int ai = 0; ai < 2; ++ai)
#pragma unroll
                for (int m = 0; m < 4; ++m) {
                    const int row = row0 + ai * 128 + m * 16;
#pragma unroll
                    for (int bj = 0; bj < 2; ++bj)
#pragma unroll
                        for (int n = 0; n < 2; ++n) { const f32x4 v = acc[ai][bj][m][n]; const int col = ct + bj * 128 + n * 16 + cw;
                            __builtin_nontemporal_store(v, (f32x4*)(of + (size_t)row * 2048 + col));
                            *(v2u*)(ob + (size_t)row * 2048 + col) = pk4(v); }
                }
        } else {
            if (wc < 2) {
                const float* cosT = (const float*)(ws + WS_COS); const float* sinT = (const float*)(ws + WS_SIN); bf16* KR = (bf16*)(ws + WS_KR);
                const int i0 = 16 * wc + 4 * fq; float* of = out + (samp ? OUT_SKR - (size_t)MP * ROPE : OUT_PKR);
#pragma unroll
                for (int ai = 0; ai < 2; ++ai)
#pragma unroll
                    for (int m = 0; m < 4; ++m) {
                        const int row = row0 + ai * 128 + m * 16; const int pos = pos_of(row);
                        const f32x4 cs = *(const f32x4*)(cosT + pos * 32 + i0), sn = *(const f32x4*)(sinT + pos * 32 + i0);
                        const f32x4 x1 = acc[ai][0][m][0], x2 = acc[ai][0][m][1];
                        const f32x4 o1 = x1 * cs - x2 * sn, o2 = x2 * cs + x1 * sn;
                        *(f32x4*)(of + (size_t)row * ROPE + i0) = o1; *(f32x4*)(of + (size_t)row * ROPE + 32 + i0) = o2;
                        *(v2u*)(KR + (size_t)row * ROPE + i0) = pk4(o1); *(v2u*)(KR + (size_t)row * ROPE + 32 + i0) = pk4(o2);
                    }
            }
        }
    }
};
struct Epi2a {
    static constexpr bool FP8 = false; static constexpr int MIXNT16 = 0;
    static constexpr bool PERM = false;
    const float *QSS, *cosT, *sinT; bf16* QM;
    __device__ __forceinline__ void operator()(const f32x4 (&acc)[2][2][4][2], const pg8::Unit& u, int wr, int wc, int fr, int fq) const {
        const int pn = u.pn; const int row0 = u.pm * 256 + wr * 64 + fr; const int cw = wc * 32 + 4 * fq;
#pragma unroll
        for (int ai = 0; ai < 2; ++ai)
#pragma unroll
            for (int m = 0; m < 4; ++m) {
                const int row = row0 + ai * 128 + m * 16;
                float ss = 0.f; const f32x4* sp = (const f32x4*)(QSS + row * 16);
#pragma unroll
                for (int j = 0; j < 4; ++j) { const f32x4 t = sp[j]; ss += (t[0] + t[1]) + (t[2] + t[3]); }
                const float sc = (1.0f / sqrtf(ss * (1.0f / QLORA) + EPS)) * MLA_QS;
                if (pn < 8) {
#pragma unroll
                    for (int bj = 0; bj < 2; ++bj)
#pragma unroll
                        for (int n = 0; n < 2; ++n) { const int col = pn * 256 + bj * 128 + n * 16 + cw; const int head = col >> 7, d = col & 127;
                            *(v2u*)(QM + (size_t)row * 3072 + head * 192 + d) = pk4(acc[ai][bj][m][n] * sc); }
                } else {
                    const int pos = pos_of(row); const int i0 = 16 * (wc & 1) + 4 * fq;
                    const f32x4 cs = *(const f32x4*)(cosT + pos * 32 + i0), sn = *(const f32x4*)(sinT + pos * 32 + i0);
#pragma unroll
                    for (int bj = 0; bj < 2; ++bj) { const int head = 4 * (pn - 8) + 2 * bj + (wc >> 1);
                        const f32x4 x1 = acc[ai][bj][m][0] * sc, x2 = acc[ai][bj][m][1] * sc;
                        const f32x4 o1 = x1 * cs - x2 * sn, o2 = x2 * cs + x1 * sn;
                        *(v2u*)(QM + (size_t)row * 3072 + head * 192 + 128 + i0) = pk4(o1); *(v2u*)(QM + (size_t)row * 3072 + head * 192 + 160 + i0) = pk4(o2); }
                }
            }
    }
};
struct Epi2b {
    static constexpr bool FP8 = false; static constexpr int MIXNT16 = 0;
    static constexpr bool PERM = false;
    const float* KVSS; bf16* KV; int rbase;
    __device__ __forceinline__ void operator()(const f32x4 (&acc)[2][2][4][2], const pg8::Unit& u, int wr, int wc, int fr, int fq) const {
        const int row0 = rbase + u.pm * 256 + wr * 64 + fr; const int cw = u.pn * 256 + wc * 32 + 4 * fq;
#pragma unroll
        for (int ai = 0; ai < 2; ++ai)
#pragma unroll
            for (int m = 0; m < 4; ++m) {
                const int row = row0 + ai * 128 + m * 16; float sc = 1.0f;
                if (row < MT) { const f32x4* sp = (const f32x4*)(KVSS + row * 8); const f32x4 a = sp[0], b = sp[1];
                    sc = 1.0f / sqrtf(((a[0] + a[1]) + (a[2] + a[3]) + (b[0] + b[1]) + (b[2] + b[3])) * (1.0f / KVLORA) + EPS); }
#pragma unroll
                for (int bj = 0; bj < 2; ++bj)
#pragma unroll
                    for (int n = 0; n < 2; ++n) *(v2u*)(KV + (size_t)row * 4096 + cw + bj * 128 + n * 16) = pk4(acc[ai][bj][m][n] * sc);
            }
    }
};
template <bool F8, bool BASE16> struct EpiRes {
    static constexpr bool PERM = false, FP8 = F8; static constexpr int MIXNT16 = 0;
    const void* base_p; const float* gate; bf16* out; bf16* slab; float oscale;
    __device__ __forceinline__ void operator()(const f32x4 (&acc)[2][2][4][2], const pg8::Unit& u, int wr, int wc, int fr, int fq) const {
        const int row0 = u.pm * 256 + wr * 64 + fr; const int cw = u.pn * 256 + wc * 32 + 4 * fq;
        if (u.split >= 0) {
            bf16* sp = slab + (size_t)u.split * MS * DM + (size_t)(wr * 64 + fr) * DM + cw;
#pragma unroll
            for (int ai = 0; ai < 2; ++ai)
#pragma unroll
                for (int m = 0; m < 4; ++m)
#pragma unroll
                    for (int bj = 0; bj < 2; ++bj)
#pragma unroll
                        for (int n = 0; n < 2; ++n) *(v2u*)(sp + (size_t)(ai * 128 + m * 16) * DM + bj * 128 + n * 16) = pk4h(acc[ai][bj][m][n] * oscale);
            return;
        }
        const int b = u.pm >> 4;
#pragma unroll
        for (int ai = 0; ai < 2; ++ai)
#pragma unroll
            for (int m = 0; m < 4; ++m) {
                const int row = row0 + ai * 128 + m * 16;
#pragma unroll
                for (int bj = 0; bj < 2; ++bj)
#pragma unroll
                    for (int n = 0; n < 2; ++n) { const int col = cw + bj * 128 + n * 16;
                        const f32x4 gt = *(const f32x4*)(gate + (size_t)b * NMOD + col);
                        const f32x4 bs = BASE16 ? up4h(*(const v2u*)((const bf16*)base_p + (size_t)row * DM + col)) : *(const f32x4*)((const float*)base_p + (size_t)row * DM + col);
                        *(v2u*)(out + (size_t)row * DM + col) = pk4h(bs + gt * (acc[ai][bj][m][n] * oscale)); }
            }
    }
};
struct EpiGU {
    static constexpr bool FP8 = false; static constexpr int MIXNT16 = GU_NT16;
    static constexpr float MIXSCALE = H8_SCALE * WGU_SCALE;
    static constexpr bool PERM = true;
    unsigned char* ACT8; float* slab;
    __device__ __forceinline__ void operator()(const f32x4 (&acc)[2][2][4][2], const pg8::Unit& u, int wr, int wc, int fr, int fq) const {
        if (u.split >= 0) {
            float* sp = slab + (size_t)u.split * 65536 + (size_t)(wr * 64 + fr) * 256 + wc * 32 + 8 * fq;
#pragma unroll
            for (int ai = 0; ai < 2; ++ai)
#pragma unroll
                for (int m = 0; m < 4; ++m)
#pragma unroll
                    for (int bj = 0; bj < 2; ++bj)
#pragma unroll
                        for (int n = 0; n < 2; ++n) *(f32x4*)(sp + (size_t)(ai * 128 + m * 16) * 256 + bj * 128 + 4 * n) = acc[ai][bj][m][n];
            return;
        }
        const int row0 = u.pm * 256 + wr * 64 + fr; const int col = u.pn * 128 + wc * 32 + 8 * fq;
#pragma unroll
        for (int ai = 0; ai < 2; ++ai)
#pragma unroll
            for (int m = 0; m < 4; ++m) {
                const int row = row0 + ai * 128 + m * 16; v2u w;
#pragma unroll
                for (int n = 0; n < 2; ++n) { const f32x4 g = acc[ai][0][m][n], up = acc[ai][1][m][n]; f32x4 r;
#pragma unroll
                    for (int e = 0; e < 4; ++e) { const float a = g[e] * up[e] * __builtin_amdgcn_rcpf(1.0f + __builtin_amdgcn_exp2f(-g[e] * (LOG2E / MIXSCALE))) * (ACT_SCALE / (MIXSCALE * MIXSCALE)); r[e] = __builtin_amdgcn_fmed3f(a, -448.0f, 448.0f); }
                    int p = __builtin_amdgcn_cvt_pk_fp8_f32(r[0], r[1], 0, false); p = __builtin_amdgcn_cvt_pk_fp8_f32(r[2], r[3], p, true);
                    if (n == 0) w.x = (unsigned)p; else w.y = (unsigned)p; }
                *(v2u*)(ACT8 + (size_t)row * DFF + col) = w;
            }
    }
};

__device__ __forceinline__ void transpose_item(const float* W, int Nsrc, bf16* WT, int K, int k0, int dst_n0, int src_col, LAS float* scr, int lane) {
    const int kh = lane >> 5, c = lane & 31;
    {
        const unsigned off0 = ((unsigned)(k0 + kh) * (unsigned)Nsrc + (unsigned)(src_col >= 0 ? src_col : 0)) * 4u, step = 8u * (unsigned)Nsrc;
        float v[32];
#pragma unroll
        for (int i = 0; i < 32; ++i) v[i] = __builtin_nontemporal_load((const float*)((const char*)W + (off0 + (unsigned)i * step)));
#pragma unroll
        for (int i = 0; i < 32; ++i) scr[(2 * i + kh) * 33 + c] = src_col >= 0 ? v[i] : 0.f;
    }
    LDS_WAIT(); asm volatile("" ::: "memory");
    const int ch = lane & 7;
#pragma unroll
    for (int j = 0; j < 4; ++j) { const int n = (lane >> 3) + 8 * j; const LAS float* s = scr + (8 * ch) * 33 + n;
        v4u o; o.x = pk2(s[0 * 33], s[1 * 33]); o.y = pk2(s[2 * 33], s[3 * 33]); o.z = pk2(s[4 * 33], s[5 * 33]); o.w = pk2(s[6 * 33], s[7 * 33]);
        *(v4u*)(WT + (size_t)(dst_n0 + n) * K + k0 + 8 * ch) = o; }
    LDS_WAIT(); asm volatile("" ::: "memory");
}
__device__ __forceinline__ void transpose_item_fp8(const float* W, int Nsrc, unsigned char* WT8, int K, int k0, int dst_n0, int src_col, float scale, LAS float* scr, int lane) {
    const int kh = lane >> 5, c = lane & 31;
    {
        const unsigned off0 = ((unsigned)(k0 + kh) * (unsigned)Nsrc + (unsigned)src_col) * 4u, step = 8u * (unsigned)Nsrc;
        float v[32];
#pragma unroll
        for (int i = 0; i < 32; ++i) v[i] = __builtin_nontemporal_load((const float*)((const char*)W + (off0 + (unsigned)i * step)));
#pragma unroll
        for (int i = 0; i < 32; ++i) scr[(2 * i + kh) * 33 + c] = v[i];
    }
    LDS_WAIT(); asm volatile("" ::: "memory");
    const int n = lane & 31, hf = lane >> 5;
    const LAS float* s = scr + (32 * hf) * 33 + n;
#pragma unroll
    for (int q = 0; q < 2; ++q) { v4u o;
#pragma unroll
        for (int d = 0; d < 4; ++d) { float f[4];
#pragma unroll
            for (int e = 0; e < 4; ++e) f[e] = __builtin_amdgcn_fmed3f(s[(16 * q + 4 * d + e) * 33] * scale, -448.0f, 448.0f);
            int p = __builtin_amdgcn_cvt_pk_fp8_f32(f[0], f[1], 0, false); p = __builtin_amdgcn_cvt_pk_fp8_f32(f[2], f[3], p, true); o[d] = (unsigned)p; }
        *(v4u*)(WT8 + (size_t)(dst_n0 + n) * K + k0 + 32 * hf + 16 * q) = o; }
    LDS_WAIT(); asm volatile("" ::: "memory");
}
__device__ __forceinline__ int rope_dim_of(int v) { return 32 * ((v >> 4) & 1) + 16 * (v >> 5) + (v & 15); }

__device__ __forceinline__ void adaln_unit(Frame& F, const Args& A, int cb, int ks) {
    const float* w_ada = A.in[8]; const float* c_p = A.in[6]; const float* c_s = A.in[7];
    float* P = WSP(float, WS_ADAP);
    LAS float* sc = (LAS float*)(F.lds + RING_OFF);
    LAS float* red = (LAS float*)(F.lds + RING_OFF + 8192);
    const int col4 = F.tid & 255, rh = F.tid >> 8;
    __syncthreads();
    for (int idx = F.tid; idx < 1280; idx += 512) { const int b = idx >> 7, kl = idx & 127; const int k = 128 * ks + kl;
        const float c = b < 2 ? c_p[b * DM + k] : c_s[(b - 2) * DM + k]; sc[kl * 10 + b] = c / (1.0f + expf(-c)); }
    __syncthreads();
    f32x4 acc[10];
#pragma unroll
    for (int b = 0; b < 10; ++b) acc[b] = (f32x4){0.f, 0.f, 0.f, 0.f};
    const float* wp = w_ada + (size_t)(128 * ks + rh) * NMOD + cb * 1024 + 4 * col4;
    for (int i0 = 0; i0 < 64; i0 += 16) {
        f32x4 wv[16];
#pragma unroll
        for (int u2 = 0; u2 < 16; ++u2) wv[u2] = __builtin_nontemporal_load((const f32x4*)(wp + (size_t)(2 * (i0 + u2)) * NMOD));
        asm volatile("" ::: "memory");
#pragma unroll
        for (int u2 = 0; u2 < 16; ++u2) {
            const LAS f32x2* sp = (const LAS f32x2*)(sc + (2 * (i0 + u2) + rh) * 10);
#pragma unroll
            for (int b2 = 0; b2 < 5; ++b2) { const f32x2 s = sp[b2]; acc[2 * b2] += wv[u2] * s[0]; acc[2 * b2 + 1] += wv[u2] * s[1]; }
        }
    }
    if (rh == 1) {
#pragma unroll
        for (int b = 0; b < 10; ++b) *(LAS f32x4*)(red + b * 1024 + 4 * col4) = acc[b];
    }
    __syncthreads();
    if (rh == 0) {
#pragma unroll
        for (int b = 0; b < 10; ++b) *(f32x4*)(P + ((size_t)ks * 10 + b) * NMOD + cb * 1024 + 4 * col4) = acc[b] + *(const LAS f32x4*)(red + b * 1024 + 4 * col4);
    }
    __syncthreads();
}
__device__ __forceinline__ void adaln_reduce(Frame& F, const Args& A, int c_lo, int c_hi) {
    const float* P = WSP(float, WS_ADAP); const float* b_ada = A.in[9]; float* MOD = WSP(float, WS_MOD);
    const int w4 = (c_hi - c_lo) / 4;
    for (int idx = blockIdx.x * 512 + F.tid; idx < 10 * w4; idx += F.G * 512) { const int b = idx / w4, c = c_lo + 4 * (idx % w4);
        f32x4 a = *(const f32x4*)(b_ada + c);
#pragma unroll 8
        for (int ks = 0; ks < 32; ++ks) a += *(const f32x4*)(P + ((size_t)ks * 10 + b) * NMOD + c);
        *(f32x4*)(MOD + (size_t)b * NMOD + c) = a; }
}
constexpr int I_1 = (DM / 64) * (N1 / 32), I_UQ = (QLORA / 64) * (3072 / 32), I_UKV = (KVLORA / 64) * (4096 / 32), I_O = (DM / 64) * (DM / 32),
              I_GU = (DM / 64) * (NGU / 32), I_D = (DFF / 64) * (DM / 32);
constexpr int I_EARLY = I_1 + I_UQ + I_UKV, NITEMS = I_EARLY + I_O + I_GU + I_D;
__device__ __forceinline__ void transpose_one(Frame& F, const Args& A, int it, LAS float* scr) {
    const int c = F.lane & 31; int r = it;
    if (r < I_1) { const int nblk = N1 / 32, kb = r / nblk, nb = r % nblk; const int n = 32 * nb + c; int src;
        if (n < 1536) src = n; else if (n < 7680) src = n + 64; else { const int v = n - 7680; src = v < 64 ? 1536 + rope_dim_of(v) : -1; }
        transpose_item(A.in[12], INCOLS, WSP(bf16, WS_W1T), DM, 64 * kb, 32 * nb, src, scr, F.lane); return; } r -= I_1;
    if (r < I_UQ) { const int nblk = 3072 / 32, kb = r / nblk, nb = r % nblk; const int n = 32 * nb + c; int src;
        if (n < 2048) src = (n >> 7) * 192 + (n & 127); else { const int cc = n - 2048; src = (cc >> 6) * 192 + 128 + rope_dim_of(cc & 63); }
        transpose_item(A.in[15], 3072, WSP(bf16, WS_WUQT), QLORA, 64 * kb, 32 * nb, src, scr, F.lane); return; } r -= I_UQ;
    if (r < I_UKV) { const int nblk = 4096 / 32, kb = r / nblk, nb = r % nblk; const int n = 32 * nb + c;
        transpose_item(n < 2048 ? A.in[16] : A.in[17], 2048, WSP(bf16, WS_WUKVT), KVLORA, 64 * kb, 32 * nb, n & 2047, scr, F.lane); return; } r -= I_UKV;
    if (r < I_O) { const int nblk = DM / 32, kb = r / nblk, nb = r % nblk;
        transpose_item(A.in[20], DM, WSP(bf16, WS_WOUTT), DM, 64 * kb, 32 * nb, 32 * nb + c, scr, F.lane); return; } r -= I_O;
    if (r < I_GU) { const int nblk = NGU / 32, kb = r / nblk, nb = r % nblk; const int n = 32 * nb + c; const int pn = n >> 8, cc = n & 255;
        if (64 * kb >= GU_KB16) transpose_item_fp8(cc < 128 ? A.in[21] : A.in[22], DFF, WSP(unsigned char, WS_WGUT) + GU_KB16, 2 * DM, 64 * kb, 32 * nb, pn * 128 + (cc & 127), WGU_SCALE, scr, F.lane);
        else transpose_item(cc < 128 ? A.in[21] : A.in[22], DFF, WSP(bf16, WS_WGUT), DM, 64 * kb, 32 * nb, pn * 128 + (cc & 127), scr, F.lane);
        return; } r -= I_GU;
    { const int nblk = DM / 32, kb = r / nblk, nb = r % nblk;
        transpose_item_fp8(A.in[23], DM, WSP(unsigned char, WS_WDT), DFF, 64 * kb, 32 * nb, 32 * nb + c, WD_SCALE, scr, F.lane); }
}
constexpr int NBG_T = (NITEMS - I_EARLY) / 64, NBG_A = 16 * 32, NBG = NBG_T + NBG_A;
constexpr int NBG_D0 = (I_O + I_GU) / 64, NBG_D = I_D / 64, NBG_MAIN = NBG - NBG_D;
static_assert((I_O + I_GU) % 64 == 0 && I_D % 64 == 0, "background queues: whole units");
static_assert((NITEMS - I_EARLY) % 64 == 0, "background transposes: whole units");
__device__ __forceinline__ void background_unit(Frame& F, const Args& A, int g) {
    if (g < NBG_T) {
        LAS float* scr = (LAS float*)(F.lds + RING_OFF + F.wave * 16384);
#pragma unroll 1
        for (int j = 0; j < 8; ++j) transpose_one(F, A, I_EARLY + 64 * g + 8 * j + F.wave, scr);
    } else { const int u = g - NBG_T; adaln_unit(F, A, 8 + (u & 15), u >> 4); }
}
__device__ __forceinline__ void background_drain(Frame& F, const Args& A, int qword, int nunits = NBG_MAIN, int skip_at = NBG_D0, int skip_len = NBG_D) {
    volatile LAS int* slot = (volatile LAS int*)(F.lds + MISC_OFF + 64);
    unsigned* head = F.ctl + qword;
    for (;;) {
        __syncthreads();
        if (F.tid == 0) *slot = (int)__hip_atomic_fetch_add(head, 1u, __ATOMIC_RELAXED, __HIP_MEMORY_SCOPE_AGENT);
        __syncthreads();
        const int idx = *slot;
        if (idx >= nunits) break;
        background_unit(F, A, idx < skip_at ? idx : idx + skip_len);
    }
}

__device__ __forceinline__ void background_take(Frame& F, const Args& A, int qword, int n) {
    volatile LAS int* slot = (volatile LAS int*)(F.lds + MISC_OFF + 64);
    unsigned* head = F.ctl + qword;
#pragma unroll 1
    for (int k = 0; k < n; ++k) {
        __syncthreads();
        if (F.tid == 0) *slot = (int)__hip_atomic_fetch_add(head, 1u, __ATOMIC_RELAXED, __HIP_MEMORY_SCOPE_AGENT);
        __syncthreads();
        const int idx = *slot;
        if (idx >= NBG_MAIN) break;
        background_unit(F, A, idx < NBG_D0 ? idx : idx + NBG_D);
    }
    __syncthreads();
}

__device__ __forceinline__ void ph_prologue(Frame& F, const Args& A, int parts) {
    if (parts & 1) { for (int u = blockIdx.x; u < 8 * 32; u += F.G) adaln_unit(F, A, u & 7, u >> 3); }
    if (parts & 16) adaln_reduce(F, A, 0, 2 * DM);
    if (parts & 2) {
        float* cosT = WSP(float, WS_COS); float* sinT = WSP(float, WS_SIN);
        for (int idx = blockIdx.x * 512 + F.tid; idx < SEQ * 32; idx += F.G * 512) { const int pos = idx >> 5, i = idx & 31;
            const double inv = exp(-(double)i * (1.0 / 32.0) * 9.210340371976184); const double a = (double)pos * inv;
            cosT[idx] = (float)cos(a); sinT[idx] = (float)sin(a); }
    }
    if (parts & 4) {
        const float* cl = A.in[2]; const float* ck = A.in[3]; bf16* LATA = WSP(bf16, WS_LATA) + (size_t)MT * KVLORA; bf16* KR = WSP(bf16, WS_KR) + (size_t)MT * ROPE;
        for (size_t i = (size_t)blockIdx.x * 512 + F.tid; i < (size_t)MC * KVLORA / 4; i += (size_t)F.G * 512) *(v2u*)(LATA + 4 * i) = pk4(*(const f32x4*)(cl + 4 * i));
        for (size_t i = (size_t)blockIdx.x * 512 + F.tid; i < (size_t)MC * ROPE / 4; i += (size_t)F.G * 512) *(v2u*)(KR + 4 * i) = pk4(*(const f32x4*)(ck + 4 * i));
    }
    if (parts & 8) {
        LAS float* scr = (LAS float*)(F.lds + RING_OFF + F.wave * 16384);
        for (int it = F.gw; it < I_EARLY; it += F.NGW) transpose_one(F, A, it, scr);
    }
}

__device__ __forceinline__ float wg_sum8(Frame& F, float v) {
    volatile LAS float* part = (volatile LAS float*)(F.lds + MISC_OFF + 256);
    __syncthreads();
    if (F.lane == 0) part[F.wave] = v;
    __syncthreads();
    float t = 0.f;
#pragma unroll
    for (int w = 0; w < 8; ++w) t += part[w];
    return t;
}
template <bool XP16>
__device__ __forceinline__ void ph_modnorm(Frame& F, const void* xp, const float* xs, const float* g, int ch_shift, int ch_scale, bf16* outb, const bf16* slab, int ch_gate, bf16* x1s) {
    const float* MOD = WSP(float, WS_MOD);
    if (XP16) for (int row = F.gw; row < MP; row += F.NGW) {
        const int b = bidx_of(row);
        f32x4 v[16]; float ss = 0.f;
#pragma unroll
        for (int j = 0; j < 8; ++j) { const int col = 8 * F.lane + 512 * j;
            if (XP16) up8h(*(const v4u*)((const bf16*)xp + (size_t)row * XPITCH + col), v[2 * j], v[2 * j + 1]);
            else { v[2 * j] = *(const f32x4*)((const float*)xp + (size_t)row * DM + col); v[2 * j + 1] = *(const f32x4*)((const float*)xp + (size_t)row * DM + col + 4); } }
#pragma unroll
        for (int j = 0; j < 16; ++j) ss += (v[j][0] * v[j][0] + v[j][1] * v[j][1]) + (v[j][2] * v[j][2] + v[j][3] * v[j][3]);
        const float rstd = 1.0f / sqrtf(wave_sum(ss) * (1.0f / DM) + EPS);
        const float* shp = MOD + (size_t)b * NMOD + ch_shift * DM; const float* scp = MOD + (size_t)b * NMOD + ch_scale * DM;
#pragma unroll
        for (int j = 0; j < 8; ++j) { const int col = 8 * F.lane + 512 * j; f32x4 o[2];
#pragma unroll
            for (int q = 0; q < 2; ++q) { const f32x4 gg = *(const f32x4*)(g + col + 4 * q), sc = *(const f32x4*)(scp + col + 4 * q), sh = *(const f32x4*)(shp + col + 4 * q);
                o[q] = v[2 * j + q] * rstd * gg * (1.0f + sc) + sh; }
            if (col >= GU_KB16) { v2u w; w.x = pk4f8(o[0], H8_SCALE); w.y = pk4f8(o[1], H8_SCALE); *(v2u*)((unsigned char*)outb + (size_t)row * (2 * DM) + GU_KB16 + col) = w; }
            else *(v4u*)(outb + (size_t)row * DM + col) = pk8(o[0], o[1]); }
    }
    if (!XP16) for (int row = F.gw; row < MP; row += F.NGW) {
        const int b = bidx_of(row);
        f32x4 v[16]; float ss = 0.f;
#pragma unroll
        for (int j = 0; j < 16; ++j) v[j] = XP16 ? up4h(*(const v2u*)((const bf16*)xp + (size_t)row * DM + 4 * F.lane + 256 * j)) : *(const f32x4*)((const float*)xp + (size_t)row * DM + 4 * F.lane + 256 * j);
#pragma unroll
        for (int j = 0; j < 16; ++j) ss += (v[j][0] * v[j][0] + v[j][1] * v[j][1]) + (v[j][2] * v[j][2] + v[j][3] * v[j][3]);
        const float rstd = 1.0f / sqrtf(wave_sum(ss) * (1.0f / DM) + EPS);
        const float* shp = MOD + (size_t)b * NMOD + ch_shift * DM; const float* scp = MOD + (size_t)b * NMOD + ch_scale * DM;
#pragma unroll
        for (int j = 0; j < 16; ++j) { const int col = 4 * F.lane + 256 * j;
            const f32x4 gg = *(const f32x4*)(g + col), sc = *(const f32x4*)(scp + col), sh = *(const f32x4*)(shp + col);
            const f32x4 o = v[j] * rstd * gg * (1.0f + sc) + sh;
            *(v2u*)(outb + (size_t)row * DM + col) = pk4(o); }
    }
    for (int sr = blockIdx.x; sr < MS; sr += F.G) {
        const int row = MP + sr, b = bidx_of(row);
        f32x4 v[2]; float ss = 0.f;
#pragma unroll
        for (int j = 0; j < 2; ++j) { const int col = 512 * F.wave + 4 * F.lane + 256 * j; v[j] = *(const f32x4*)(xs + (size_t)sr * DM + col);
            if (slab != nullptr) { f32x4 a = (f32x4){0.f, 0.f, 0.f, 0.f};
#pragma unroll
                for (int sI = 0; sI < 16; ++sI) a += up4h(*(const v2u*)(slab + ((size_t)sI * MS + sr) * DM + col));
                v[j] += *(const f32x4*)(MOD + (size_t)b * NMOD + ch_gate * DM + col) * a;
                *(v2u*)(x1s + (size_t)sr * DM + col) = pk4h(v[j]); }
            ss += (v[j][0] * v[j][0] + v[j][1] * v[j][1]) + (v[j][2] * v[j][2] + v[j][3] * v[j][3]); }
        const float rstd = 1.0f / sqrtf(wg_sum8(F, wave_sum(ss)) * (1.0f / DM) + EPS);
        const float* shp = MOD + (size_t)b * NMOD + ch_shift * DM; const float* scp = MOD + (size_t)b * NMOD + ch_scale * DM;
#pragma unroll
        for (int j = 0; j < 2; ++j) { const int col = 512 * F.wave + 4 * F.lane + 256 * j;
            const f32x4 gg = *(const f32x4*)(g + col), sc = *(const f32x4*)(scp + col), sh = *(const f32x4*)(shp + col);
            const f32x4 o = v[j] * rstd * gg * (1.0f + sc) + sh;
            if (XP16 && col >= GU_KB16) *(unsigned*)((unsigned char*)outb + (size_t)row * (2 * DM) + GU_KB16 + col) = pk4f8(o, H8_SCALE);
            else *(v2u*)(outb + (size_t)row * DM + col) = pk4(o); }
    }
}

__device__ __forceinline__ void ph_latent_finalize(Frame& F, const Args& A) {
    const float* KVSS = WSP(float, WS_KVSS); const float* g = A.in[14];
    for (int row = F.gw; row < MT; row += F.NGW) {
        float* p = row < MP ? F.out + OUT_PLAT + (size_t)row * KVLORA : F.out + OUT_SLAT + (size_t)(row - MP) * KVLORA;
        const f32x4 a = *(const f32x4*)(KVSS + row * 8), b = *(const f32x4*)(KVSS + row * 8 + 4);
        const float rstd = 1.0f / sqrtf(((a[0] + a[1]) + (a[2] + a[3]) + (b[0] + b[1]) + (b[2] + b[3])) * (1.0f / KVLORA) + EPS);
#pragma unroll
        for (int j = 0; j < 2; ++j) { const int col = 4 * F.lane + 256 * j; f32x4 v = *(const f32x4*)(p + col); const f32x4 gg = *(const f32x4*)(g + col);
            *(f32x4*)(p + col) = v * rstd * gg; }
    }
}

__device__ __forceinline__ void ph_merge_norm(Frame& F, const Args& A) {
    const float* OSS = WSP(float, WS_OSS); bf16* O = WSP(bf16, WS_O); const float* gm = A.in[18]; const float* gs = A.in[19];
    for (int row = F.gw; row < MT; row += F.NGW) {
        float s0 = 0.f, s1 = 0.f;
#pragma unroll
        for (int j = 0; j < 4; ++j) { const f32x4 a = *(const f32x4*)(OSS + row * 32 + 4 * j), b = *(const f32x4*)(OSS + row * 32 + 16 + 4 * j); s0 += (a[0] + a[1]) + (a[2] + a[3]); s1 += (b[0] + b[1]) + (b[2] + b[3]); }
        const float r0 = 1.0f / sqrtf(s0 * (1.0f / 2048.0f) + EPS), r1 = 1.0f / sqrtf(s1 * (1.0f / 2048.0f) + EPS);
#pragma unroll
        for (int j = 0; j < 8; ++j) { const int col = 8 * F.lane + 512 * j; const float r = col < 2048 ? r0 : r1; const float* gp = col < 2048 ? gm + col : gs + (col - 2048);
            const v4u w = *(const v4u*)(O + (size_t)row * DM + col); const f32x4 g0 = *(const f32x4*)gp, g1 = *(const f32x4*)(gp + 4);
            f32x4 a, b; a[0] = __uint_as_float(w.x << 16); a[1] = __uint_as_float(w.x & 0xffff0000u); a[2] = __uint_as_float(w.y << 16); a[3] = __uint_as_float(w.y & 0xffff0000u);
            b[0] = __uint_as_float(w.z << 16); b[1] = __uint_as_float(w.z & 0xffff0000u); b[2] = __uint_as_float(w.w << 16); b[3] = __uint_as_float(w.w & 0xffff0000u);
            const v2u pa = pk4(a * r * g0), pb = pk4(b * r * g1); v4u o; o.x = pa.x; o.y = pa.y; o.z = pb.x; o.w = pb.y;
            *(v4u*)(O + (size_t)row * DM + col) = o; }
    }
}

__device__ __forceinline__ void ph_final_norm(Frame& F, const Args& A) {
    const float* g = A.in[24]; const float* MOD = WSP(float, WS_MOD); const bf16* slab = WSP(bf16, WS_SLAB); const bf16* X1 = WSP(bf16, WS_X1); const bf16* X2 = WSP(bf16, WS_X2);
    for (int row = F.gw; row < MP; row += F.NGW) {
        float* p = F.out + OUT_Y + (size_t)row * DM;
        f32x4 v[16]; float ss = 0.f;
#pragma unroll
        for (int j = 0; j < 16; ++j) v[j] = up4h(*(const v2u*)(X2 + (size_t)row * DM + 4 * F.lane + 256 * j));
#pragma unroll
        for (int j = 0; j < 16; ++j) ss += (v[j][0] * v[j][0] + v[j][1] * v[j][1]) + (v[j][2] * v[j][2] + v[j][3] * v[j][3]);
        const float rstd = 1.0f / sqrtf(wave_sum(ss) * (1.0f / DM) + EPS);
#pragma unroll
        for (int j = 0; j < 16; ++j) { const int col = 4 * F.lane + 256 * j; __builtin_nontemporal_store(v[j] * rstd * *(const f32x4*)(g + col), (f32x4*)(p + col)); }
    }
    for (int sr = blockIdx.x; sr < MS; sr += F.G) {
        const int row = MP + sr; float* p = F.out + OUT_Y + (size_t)row * DM;
        const float* gp = MOD + (size_t)bidx_of(row) * NMOD + 5 * DM;
        f32x4 v[2]; float ss = 0.f;
#pragma unroll
        for (int j = 0; j < 2; ++j) { const int col = 512 * F.wave + 4 * F.lane + 256 * j; f32x4 a = (f32x4){0.f, 0.f, 0.f, 0.f};
#pragma unroll
            for (int sI = 0; sI < 16; ++sI) a += up4h(*(const v2u*)(slab + ((size_t)sI * MS + sr) * DM + col));
            v[j] = up4h(*(const v2u*)(X1 + (size_t)row * DM + col)) + *(const f32x4*)(gp + col) * a;
            ss += (v[j][0] * v[j][0] + v[j][1] * v[j][1]) + (v[j][2] * v[j][2] + v[j][3] * v[j][3]); }
        const float rstd = 1.0f / sqrtf(wg_sum8(F, wave_sum(ss)) * (1.0f / DM) + EPS);
#pragma unroll
        for (int j = 0; j < 2; ++j) { const int col = 512 * F.wave + 4 * F.lane + 256 * j; __builtin_nontemporal_store(v[j] * rstd * *(const f32x4*)(g + col), (f32x4*)(p + col)); }
    }
}

__device__ __forceinline__ int crow(int i, int h) { return (i & 3) + 8 * (i >> 2) + 4 * h; }
__device__ __forceinline__ unsigned voff_b(unsigned row, unsigned ch) { return 256u * row + 16u * (ch ^ (((row & 3u) << 2) | ((row >> 2) & 3u))); }
__device__ __forceinline__ v4u cvt8(const float* p) { const f32x4 a = *(const f32x4*)p, b = *(const f32x4*)(p + 4); const v2u x = pk4(a), y = pk4(b); v4u o; o.x = x.x; o.y = x.y; o.z = y.x; o.w = y.y; return o; }

template <int MODE>
__device__ __forceinline__ void attn_unit(Frame& F, const float* csk, const float* csv, bool sample, int b, int h, int qb) {
    constexpr int DQK = MODE == 0 ? 192 : 128, NS = DQK / 16, KP = DQK * 2 + 16, KCH = DQK / 8, NKC = KCH / 8;
    constexpr int VP = 320;
    constexpr int LDS_K = 0, LDS_V = 64 * KP, BUFB = LDS_V + 64 * VP;
    LAS unsigned char* lds = F.lds + RING_OFF;
    volatile LAS int* flags = (volatile LAS int*)(F.lds + MISC_OFF + 128);
    const int lane = F.lane, wave = F.wave, tid = F.tid, l31 = lane & 31, hh = lane >> 5;
    const int qrow0 = sample ? MP + 32 * b : b * SEQ + 256 * qb;
    const int qpos0 = sample ? PAST : 256 * qb;
    const bool wact = sample ? (wave == 0) : true;
    const int qrow = qrow0 + 32 * wave + l31, qpos = qpos0 + 32 * wave + l31;
    const bf16* KVb = WSP(bf16, WS_KV); const bf16* KRb = WSP(bf16, WS_KR);
    const bf16* SBKb = WSP(bf16, WS_SBK); const bf16* SBVb = WSP(bf16, WS_SBV);
    bf16x8 qf[NS];
    if (wact) {
        const bf16* qp = MODE == 0 ? WSP(bf16, WS_QM) + (size_t)qrow * 3072 + h * 192 + 8 * hh : WSP(bf16, WS_SBQ) + (size_t)qrow * 2048 + h * 128 + 8 * hh;
#pragma unroll
        for (int s = 0; s < NS; ++s) qf[s] = *(const bf16x8*)(qp + 16 * s);
    } else {
#pragma unroll
        for (int s = 0; s < NS; ++s) qf[s] = (bf16x8){0, 0, 0, 0, 0, 0, 0, 0};
    }
    f32x16 o[4];
#pragma unroll
    for (int c = 0; c < 4; ++c)
#pragma unroll
        for (int i = 0; i < 16; ++i) o[c][i] = 0.f;
    float mrun = -INFINITY, lrun = 0.f, prun = 1.0f;
    bool started = false, started0 = false, wdone = false;
    const int nblk = sample ? 33 : 4 * qb + 4;
    const unsigned tq = (lane & 15) >> 2, tp = lane & 3, tblk = (lane >> 4) & 1;
#define BLK_J(it) (MODE == 0 ? (it) : nblk - 1 - (it))
#define BLK_NEW(j) (sample && (j) == 32)
#define BLK_ROW(j) (sample ? (BLK_NEW(j) ? MP + 32 * b : MT + b * PAST + 64 * (j)) : b * SEQ + 64 * (j))
#define BLK_F32(j) (MODE == 1 && sample && !BLK_NEW(j))
    v4u pk[NKC], pv[2];
    const int r0 = tid >> 4, chv = tid & 15, rr = tid >> 3, chr = tid & 7;
    constexpr unsigned SRCP = MODE == 0 ? 8192u : 4096u;
    const unsigned goff = (unsigned)r0 * SRCP + 16u * chv + (unsigned)h * 256u;
    const unsigned lk0 = (unsigned)r0 * KP + 16u * chv, lv0 = (unsigned)r0 * VP + 16u * chv, lkr = (unsigned)rr * KP + 256u + 16u * chr;
#define ISSUE(j) do { if (!BLK_F32(j)) { const int krow_ = BLK_ROW(j); \
        const char* kb_ = (const char*)(MODE == 0 ? KVb : SBKb) + (size_t)krow_ * SRCP; const char* vb_ = MODE == 0 ? kb_ + 4096 : (const char*)SBVb + (size_t)krow_ * SRCP; \
        pk[0] = *(const v4u*)(kb_ + goff); pk[1] = *(const v4u*)(kb_ + goff + 32u * SRCP); \
        if (MODE == 0) pk[NKC - 1] = *(const v4u*)((const char*)KRb + (size_t)krow_ * 128 + rr * 128 + 16 * chr); \
        pv[0] = *(const v4u*)(vb_ + goff); pv[1] = *(const v4u*)(vb_ + goff + 32u * SRCP); } } while (0)
#define WRITE(j, bufo) do { const bool half_ = BLK_NEW(j); \
        if (BLK_F32(j)) { const size_t fo_ = ((size_t)(b * PAST + 64 * (j)) * NH + h) * SBD + (size_t)r0 * (NH * SBD) + 8 * chv; \
            pk[0] = cvt8(csk + fo_); pk[1] = cvt8(csk + fo_ + 32 * NH * SBD); pv[0] = cvt8(csv + fo_); pv[1] = cvt8(csv + fo_ + 32 * NH * SBD); } \
        const v4u z_ = (v4u){0u, 0u, 0u, 0u}; \
        *(LAS v4u*)(lds + (bufo) + LDS_K + lk0) = pk[0]; *(LAS v4u*)(lds + (bufo) + LDS_K + lk0 + 32 * KP) = half_ ? z_ : pk[1]; \
        if (MODE == 0) *(LAS v4u*)(lds + (bufo) + LDS_K + lkr) = (half_ && rr >= 32) ? z_ : pk[NKC - 1]; \
        *(LAS v4u*)(lds + (bufo) + LDS_V + lv0) = pv[0]; *(LAS v4u*)(lds + (bufo) + LDS_V + lv0 + 32 * VP) = half_ ? z_ : pv[1]; } while (0)
#pragma unroll
    for (int i = 0; i < NKC; ++i) pk[i] = (v4u){0u, 0u, 0u, 0u};
    pv[0] = (v4u){0u, 0u, 0u, 0u}; pv[1] = (v4u){0u, 0u, 0u, 0u};
    ISSUE(BLK_J(0));
    int bufo = 0;
    for (int it = 0; it < nblk; ++it) {
        const int j = BLK_J(it);
        const int kpos0 = 64 * j, nvalid = BLK_NEW(j) ? 32 : 64;
        WRITE(j, bufo);
        if (it + 1 < nblk) { const int jn = BLK_J(it + 1); ISSUE(jn); }
        __syncthreads();
        if (MODE == 1 && it > 0) { const int f = flags[((it - 1) & 1) * 8 + (lane & 7)]; if (__all(f != 0)) break; }
        bool need;
        if (MODE == 0) need = wact && (sample || j <= ((256 * qb + 32 * wave) >> 6));
        else need = wact && !wdone && (kpos0 < qpos0 + 32 * wave + 31);
        if (need) {
            started = true;
            LAS unsigned char* kb = lds + bufo + LDS_K; LAS unsigned char* vb = lds + bufo + LDS_V;
            bf16x8 pf[4];
            if (MODE == 0) {
                const LAS unsigned char* vl = vb + (4 * hh + tq) * VP + 32 * tblk + 8 * tp;
                const bool two = nvalid > 32;
                f32x16 s0, s1; const float nref = started0 ? -mrun : 0.f;
#pragma unroll
                for (int i = 0; i < 16; ++i) { s0[i] = nref; s1[i] = nref; }
                {
                    constexpr int PF = 3, NF = 2 * NS;
                    const int nf = two ? NF : NS;
                    bf16x8 kq[PF];
#define KFRAG(f) (*(const LAS bf16x8*)(kb + (((f) >= NS ? 32 : 0) + l31) * KP + 32 * ((f) >= NS ? (f) - NS : (f)) + 16 * hh))
#pragma unroll
                    for (int f = 0; f < PF; ++f) kq[f] = KFRAG(f);
                    __builtin_amdgcn_sched_barrier(0);
#pragma unroll
                    for (int f = 0; f < NF; ++f) {
                        if (f < NS || two) {
                            const bf16x8 kc = kq[f % PF];
                            if (f + PF < NF && (f + PF < NS || two)) kq[f % PF] = KFRAG(f + PF);
                            if (f < NS) s0 = __builtin_amdgcn_mfma_f32_32x32x16_bf16(kc, qf[f], s0, 0, 0, 0);
                            else s1 = __builtin_amdgcn_mfma_f32_32x32x16_bf16(kc, qf[f - NS], s1, 0, 0, 0);
                            __builtin_amdgcn_sched_barrier(0);
                        }
                    }
#undef KFRAG
                    (void)nf;
                }
                __builtin_amdgcn_sched_barrier(0);
#define MLA_HALF(SV, KS0, FIX_OTHER) do { \
                    float mx_ = SV[0]; \
                    _Pragma("unroll") for (int i = 1; i < 16; ++i) mx_ = fmaxf(mx_, SV[i]); \
                    mx_ = fmaxf(mx_, __shfl_xor(mx_, 32)); \
                    if (__any(!started0 || mx_ > 8.0f)) {     \
                        const float dl_ = started0 ? fmaxf(mx_, 0.f) : mx_; const float alpha_ = started0 ? __builtin_amdgcn_exp2f(-dl_) : 0.f; \
                        mrun = started0 ? mrun + dl_ : dl_; lrun *= alpha_; \
                        _Pragma("unroll") for (int i = 0; i < 16; ++i) SV[i] -= dl_; \
                        if (FIX_OTHER) { _Pragma("unroll") for (int i = 0; i < 16; ++i) s1[i] -= dl_; } \
                        _Pragma("unroll") for (int c = 0; c < 4; ++c) _Pragma("unroll") for (int i = 0; i < 16; ++i) o[c][i] *= alpha_; \
                    } \
                    started0 = true; \
                    float ps_ = 0.f; \
                    _Pragma("unroll") for (int i = 0; i < 16; ++i) { SV[i] = __builtin_amdgcn_exp2f(SV[i]); ps_ += SV[i]; } \
                    lrun += ps_; \
                    _Pragma("unroll") for (int s2 = 0; s2 < 2; ++s2) { const int r0_ = 8 * s2; v4u w; \
                        w.x = pk2(SV[r0_], SV[r0_ + 1]); w.y = pk2(SV[r0_ + 2], SV[r0_ + 3]); w.z = pk2(SV[r0_ + 4], SV[r0_ + 5]); w.w = pk2(SV[r0_ + 6], SV[r0_ + 7]); \
                        pf[(KS0) + s2] = __builtin_bit_cast(bf16x8, w); } \
                    {     \
                        s16x4 vlo_[3], vhi_[3]; \
                        _Pragma("unroll") for (int f = 0; f < 2; ++f) { const int ks = (KS0) + (f >> 2), c = f & 3; \
                            vlo_[f] = __builtin_bit_cast(s16x4, __builtin_amdgcn_ds_read_tr16_b64_v4i16((LAS s16x4*)(vl + (16 * ks) * VP + 64 * c))); \
                            vhi_[f] = __builtin_bit_cast(s16x4, __builtin_amdgcn_ds_read_tr16_b64_v4i16((LAS s16x4*)(vl + (16 * ks + 8) * VP + 64 * c))); } \
                        _Pragma("unroll") for (int f = 0; f < 8; ++f) { const int ks = (KS0) + (f >> 2), c = f & 3; \
                            if (f + 2 < 8) { const int ks2 = (KS0) + ((f + 2) >> 2), c2 = (f + 2) & 3; \
                                vlo_[(f + 2) % 3] = __builtin_bit_cast(s16x4, __builtin_amdgcn_ds_read_tr16_b64_v4i16((LAS s16x4*)(vl + (16 * ks2) * VP + 64 * c2))); \
                                vhi_[(f + 2) % 3] = __builtin_bit_cast(s16x4, __builtin_amdgcn_ds_read_tr16_b64_v4i16((LAS s16x4*)(vl + (16 * ks2 + 8) * VP + 64 * c2))); } \
                            const bf16x8 vf = __builtin_shufflevector(vlo_[f % 3], vhi_[f % 3], 0, 1, 2, 3, 4, 5, 6, 7); \
                            o[c] = __builtin_amdgcn_mfma_f32_32x32x16_bf16(vf, pf[ks], o[c], 0, 0, 0); } \
                        __builtin_amdgcn_sched_barrier(0); } } while (0)
                MLA_HALF(s0, 0, two);
                if (two) MLA_HALF(s1, 2, false);
#undef MLA_HALF
            } else {
#pragma unroll
                for (int tI = 1; tI >= 0; --tI) {
                    f32x16 sv;
#pragma unroll
                    for (int i = 0; i < 16; ++i) sv[i] = 0.f;
                    {
                        constexpr int PFK = 3; bf16x8 kq[PFK];
#define KFRAG1(f) (*(const LAS bf16x8*)(kb + (32 * tI + l31) * KP + 32 * (f) + 16 * hh))
#pragma unroll
                        for (int f = 0; f < PFK; ++f) kq[f] = KFRAG1(f);
                        __builtin_amdgcn_sched_barrier(0);
#pragma unroll
                        for (int f = 0; f < NS; ++f) { const bf16x8 kc = kq[f % PFK];
                            if (f + PFK < NS) kq[f % PFK] = KFRAG1(f + PFK);
                            sv = __builtin_amdgcn_mfma_f32_32x32x16_bf16(kc, qf[f], sv, 0, 0, 0);
                            __builtin_amdgcn_sched_barrier(0); }
#undef KFRAG1
                    }
                    float kp[16];
                    const int lim = min(qpos - kpos0, nvalid) - 32 * tI;
#pragma unroll
                    for (int i = 0; i < 16; ++i) { const bool ok = crow(i, hh) < lim;
                        const float z = __builtin_amdgcn_fmed3f(sv[i], -126.0f, 126.0f); const float e = __builtin_amdgcn_exp2f(-z); const float r = __builtin_amdgcn_rcpf(1.0f + e);
                        kp[i] = ok ? e * r : 1.0f; sv[i] = ok ? r : 0.f; }
                    float G[4], Go[4];
#pragma unroll
                    for (int g = 0; g < 4; ++g) { G[g] = (kp[4 * g] * kp[4 * g + 1]) * (kp[4 * g + 2] * kp[4 * g + 3]); Go[g] = __shfl_xor(G[g], 32); }
                    float later = prun;
#pragma unroll
                    for (int g = 3; g >= 0; --g) {
                        float tl = hh == 0 ? later * Go[g] : later;
#pragma unroll
                        for (int e = 3; e >= 0; --e) { const int i = 4 * g + e; sv[i] *= tl; tl *= kp[i]; }
                        later *= G[g] * Go[g];
                    }
                    prun = later;
#pragma unroll
                    for (int s2 = 0; s2 < 2; ++s2) { const int r0_ = 8 * s2; v4u w;
                        w.x = pk2(sv[r0_], sv[r0_ + 1]); w.y = pk2(sv[r0_ + 2], sv[r0_ + 3]); w.z = pk2(sv[r0_ + 4], sv[r0_ + 5]); w.w = pk2(sv[r0_ + 6], sv[r0_ + 7]);
                        pf[2 * tI + s2] = __builtin_bit_cast(bf16x8, w); }
                    __builtin_amdgcn_sched_barrier(0);
                }
            }
            if (MODE == 1) {
                const LAS unsigned char* vl = vb + (4 * hh + tq) * VP + 32 * tblk + 8 * tp;
                s16x4 vlo_[3], vhi_[3];
#define VFRAG1(f, slot) do { const int ks_ = (f) >> 2, c_ = (f) & 3; \
                    vlo_[slot] = __builtin_bit_cast(s16x4, __builtin_amdgcn_ds_read_tr16_b64_v4i16((LAS s16x4*)(vl + (16 * ks_) * VP + 64 * c_))); \
                    vhi_[slot] = __builtin_bit_cast(s16x4, __builtin_amdgcn_ds_read_tr16_b64_v4i16((LAS s16x4*)(vl + (16 * ks_ + 8) * VP + 64 * c_))); } while (0)
                VFRAG1(0, 0); VFRAG1(1, 1);
                __builtin_amdgcn_sched_barrier(0);
#pragma unroll
                for (int f = 0; f < 16; ++f) {
                    if (f + 2 < 16) VFRAG1(f + 2, (f + 2) % 3);
                    const bf16x8 vf = __builtin_shufflevector(vlo_[f % 3], vhi_[f % 3], 0, 1, 2, 3, 4, 5, 6, 7);
                    o[f & 3] = __builtin_amdgcn_mfma_f32_32x32x16_bf16(vf, pf[f >> 2], o[f & 3], 0, 0, 0);
                    __builtin_amdgcn_sched_barrier(0);
                }
#undef VFRAG1
            }
        }
        if (MODE == 1) {
            wdone = started && __all(prun < 1.1102230246251565e-16f);
            if (lane == 0) flags[(it & 1) * 8 + wave] = (!wact || wdone) ? 1 : 0;
        }
        bufo ^= BUFB;
    }
#undef BLK_J
#undef BLK_NEW
#undef BLK_ROW
#undef BLK_F32
#undef ISSUE
#undef WRITE
    if (wact) {
        float inv = 1.0f;
        if (MODE == 0) { const float lt = lrun + __shfl_xor(lrun, 32); inv = 1.0f / lt; }
        bf16* Ob = WSP(bf16, WS_O) + (size_t)qrow * DM + (MODE == 0 ? 0 : 2048) + h * 128;
        float ss = 0.f;
#pragma unroll
        for (int c = 0; c < 4; ++c)
#pragma unroll
            for (int g = 0; g < 4; ++g) { f32x4 v; v[0] = o[c][4 * g] * inv; v[1] = o[c][4 * g + 1] * inv; v[2] = o[c][4 * g + 2] * inv; v[3] = o[c][4 * g + 3] * inv;
                ss += (v[0] * v[0] + v[1] * v[1]) + (v[2] * v[2] + v[3] * v[3]);
                *(v2u*)(Ob + 32 * c + 8 * g + 4 * hh) = pk4(v); }
        ss += __shfl_xor(ss, 32);
        if (hh == 0) WSP(float, WS_OSS)[qrow * 32 + (MODE == 0 ? 0 : 16) + h] = ss;
    }
}

__device__ __forceinline__ void ph_attention(Frame& F, const Args& A, int qword, int mask) {
    const float* csk = A.in[4]; const float* csv = A.in[5];
    volatile LAS int* slot = (volatile LAS int*)(F.lds + MISC_OFF + 64);
    unsigned* head = F.ctl + qword;
    for (;;) {
        __syncthreads();
        if (F.tid == 0) *slot = (int)__hip_atomic_fetch_add(head, 1u, __ATOMIC_RELAXED, __HIP_MEMORY_SCOPE_AGENT);
        __syncthreads();
        const int id = *slot;
        if (id >= 1280) break;
        if (id < 128) { if (mask & 1) attn_unit<0>(F, csk, csv, true, id >> 4, id & 15, 0); }
        else if (id < 256) { const int bh = id - 128; if (mask & 2) attn_unit<1>(F, csk, csv, true, bh >> 4, bh & 15, 0); }
        else { const int pid = id - 256; const int qb = 15 - (pid >> 6), jj = pid & 63, bh = jj >> 1; if (jj & 1) { if (mask & 8) attn_unit<1>(F, csk, csv, false, bh >> 4, bh & 15, qb); } else { if (mask & 4) attn_unit<0>(F, csk, csv, false, bh >> 4, bh & 15, qb); } }
    }
}

constexpr int NPHASE = 11;
__global__ void __launch_bounds__(NWAVES * 64, 2) mk_fwd(Args args) {
    extern __shared__ __attribute__((aligned(16))) unsigned char lds[];
    Frame F;
    F.lds = (LAS unsigned char*)lds;
    F.MISC = (volatile LAS unsigned*)(F.lds + MISC_OFF);
    F.tid = threadIdx.x; F.lane = F.tid & 63; F.wave = __builtin_amdgcn_readfirstlane(F.tid >> 6);
    F.G = gridDim.x; F.gw = blockIdx.x * NWAVES + F.wave; F.NGW = F.G * NWAVES;
    F.ws = args.ws; F.ctl = (unsigned*)(args.ws + WS_CTL); F.out = args.out;
    for (int u = F.tid; u < (LDS_BYTES - LDSCTL_OFF) / 4; u += NWAVES * 64) ((LAS unsigned*)(F.lds + LDSCTL_OFF))[u] = 0u;
    __syncthreads();
    XcdBarrier bar; bar.bar = F.ctl + CW_BAR; bar.x = 0; bar.st = nullptr;
    const int lo = args.ph_lo, hi = args.ph_hi;
    bar = xcd_barrier_post(F.ctl + CW_BAR, F.MISC + 8);
#define IN(k) (lo <= (k) && (k) < hi)
#define SEAM(k) do { if (IN(k) && IN((k) + 1)) xcd_barrier(bar); } while (0)

#define DUP(k, ...) do { __VA_ARGS__ if (PROBE_DUP == (k)) { xcd_barrier(bar); __VA_ARGS__ } } while (0)
    if (IN(0)) { ph_prologue(F, args, 1); xcd_barrier(bar); ph_prologue(F, args, 2 | 4 | 8 | 16); if (PROBE_DUP >= 100 && PROBE_DUP < 132) { xcd_barrier(bar); ph_prologue(F, args, PROBE_DUP - 100); } } SEAM(0);
    if (IN(1)) { DUP(1, ph_modnorm<false>(F, args.in[0], args.in[1], args.in[10], 0, 1, WSP(bf16, WS_H), nullptr, 0, nullptr);); } SEAM(1);
    if (IN(2)) {
        DUP(20,
        {
            pg8::Gemm g{WSP(bf16, WS_H), WSP(bf16, WS_W1T), MT, N1, DM}; pg8::StaticOrder S; S.init(MT, N1, F.G, (int)blockIdx.x, DM);
            Epi1 E{args.in[13], args.in[14], F.ws, F.out};
            pg8::gemm_phase<Epi1, pg8::StaticOrder, PG8_ALIGN, PG8_SP2>(F.lds + RING_OFF, g, S, E);
        });
        { const int nwg1 = (MT / 256) * (N1 / 256), lastfull = nwg1 % F.G;
          if (lastfull != 0 && (int)blockIdx.x >= lastfull) background_take(F, args, CW_QUEUE + 128, 4); }
    } SEAM(2);
    if (IN(3)) {
        DUP(3,
        {
            pg8::Gemm g{WSP(bf16, WS_LATA), WSP(bf16, WS_WUKVT), MP, 4096, KVLORA}; pg8::StaticOrder S; S.init(MP, 4096, F.G, (int)blockIdx.x, KVLORA);
            Epi2b E{WSP(float, WS_KVSS), WSP(bf16, WS_KV), 0};
            pg8::gemm_phase<Epi2b, pg8::StaticOrder, PG8_ALIGN, PG8_SP2>(F.lds + RING_OFF, g, S, E);
        }
        {
            pg8::Gemm g{WSP(bf16, WS_A2A), WSP(bf16, WS_WUQT), MT, 3072, QLORA}; pg8::StaticOrder S; S.init(MT, 3072, F.G, (int)blockIdx.x, QLORA);
            Epi2a E{WSP(float, WS_QSS), WSP(float, WS_COS), WSP(float, WS_SIN), WSP(bf16, WS_QM)};
            pg8::gemm_phase<Epi2a, pg8::StaticOrder, PG8_ALIGN, PG8_SP2>(F.lds + RING_OFF, g, S, E);
        }
        {
            const int first_idle = ((MT / 256) * (3072 / 256)) % F.G; const int cs = (int)blockIdx.x >= first_idle ? (int)blockIdx.x - first_idle : (1 << 24);
            pg8::Gemm g{WSP(bf16, WS_LATA) + (size_t)MP * KVLORA, WSP(bf16, WS_WUKVT), MS, 4096, KVLORA}; pg8::StaticOrder S; S.init(MS, 4096, F.G, cs, KVLORA);
            Epi2b E{WSP(float, WS_KVSS), WSP(bf16, WS_KV), MP};
            pg8::gemm_phase<Epi2b, pg8::StaticOrder, PG8_ALIGN, PG8_SP2>(F.lds + RING_OFF, g, S, E);
        });
        DUP(21,
        {
            pg8::Gemm g{WSP(bf16, WS_LATA) + (size_t)MT * KVLORA, WSP(bf16, WS_WUKVT), MC, 4096, KVLORA}; pg8::StaticOrder S; S.init(MC, 4096, F.G, (int)blockIdx.x, KVLORA);
            Epi2b E{WSP(float, WS_KVSS), WSP(bf16, WS_KV), MT};
            pg8::gemm_phase<Epi2b, pg8::StaticOrder, PG8_ALIGN, PG8_SP2>(F.lds + RING_OFF, g, S, E);
        });
        {
            const int first_idle = ((MT / 256) * (3072 / 256)) % F.G;
            if ((int)blockIdx.x >= first_idle + (MS / 256) * 16) background_take(F, args, CW_QUEUE + 128, 1);
        }
        ph_latent_finalize(F, args);
    } SEAM(3);
    if (IN(4)) {
        if (blockIdx.x & 1) background_drain(F, args, CW_QUEUE + 128);
        ph_attention(F, args, CW_QUEUE, 15);
        background_drain(F, args, CW_QUEUE + 128);
        if (PROBE_DUP >= 40 && PROBE_DUP < 56) { xcd_barrier(bar); ph_attention(F, args, CW_QUEUE + 64, PROBE_DUP - 40); }
        if (PROBE_DUP == 57) { xcd_barrier(bar); if (blockIdx.x & 1) background_drain(F, args, CW_QUEUE + 256); ph_attention(F, args, CW_QUEUE + 64, 15); background_drain(F, args, CW_QUEUE + 256); }
        if (PROBE_DUP == 58) { xcd_barrier(bar); background_drain(F, args, CW_QUEUE + 256); }
    } SEAM(4);
    if (IN(5)) { adaln_reduce(F, args, 2 * DM, NMOD); ph_merge_norm(F, args); } SEAM(5);
    if (IN(6)) {
        DUP(6,
        { pg8::Gemm g{WSP(bf16, WS_O), WSP(bf16, WS_WOUTT), MT, DM, DM}; pg8::TailSplitOrder S; S.init(MP, DM, F.G, (int)blockIdx.x, DM, MP / 256);
        EpiRes<false, false> E{args.in[0], WSP(float, WS_MOD) + 2 * DM, WSP(bf16, WS_X1), WSP(bf16, WS_SLAB), 1.0f};
        pg8::gemm_phase<EpiRes<false, false>, pg8::TailSplitOrder, PG8_ALIGN, PG8_SP2>(F.lds + RING_OFF, g, S, E); });
    } SEAM(6);
    if (IN(7)) { DUP(7, ph_modnorm<true>(F, WSP(bf16, WS_X1), args.in[1], args.in[11], 3, 4, WSP(bf16, WS_H), WSP(bf16, WS_SLAB), 2, WSP(bf16, WS_X1) + (size_t)MP * DM);); } SEAM(7);
    if (IN(8)) {
        DUP(8,
        { pg8::Gemm g{WSP(bf16, WS_H), WSP(bf16, WS_WGUT), MT, NGU, DM}; pg8::StaticOrder S; S.init(MT, NGU, F.G, (int)blockIdx.x, GU_NT * 64);
        EpiGU E{WSP(unsigned char, WS_ACT), WSP(float, WS_SLAB)};
        pg8::gemm_phase<EpiGU, pg8::StaticOrder, PG8_ALIGN, PG8_SP2>(F.lds + RING_OFF, g, S, E); });
        background_drain(F, args, CW_QUEUE + 384, NBG_D, 0, NBG_D0);
    } SEAM(8);
    if (IN(9)) {
        DUP(9,
        { pg8::Gemm g{WSP(bf16, WS_ACT), WSP(bf16, WS_WDT), MT, DM, DFF / 2}; pg8::TailSplitOrder S; S.init(MP, DM, F.G, (int)blockIdx.x, DFF / 2, MP / 256);
        EpiRes<true, true> E{WSP(bf16, WS_X1), WSP(float, WS_MOD) + 5 * DM, WSP(bf16, WS_X2), WSP(bf16, WS_SLAB), 1.0f / (ACT_SCALE * WD_SCALE)};
        pg8::gemm_phase<EpiRes<true, true>, pg8::TailSplitOrder, PG8_ALIGN, PG8_SP2>(F.lds + RING_OFF, g, S, E); });
    } SEAM(9);
    if (IN(10)) { ph_final_norm(F, args); }
#undef DUP
#undef IN
#undef SEAM
}

extern "C" void kernel_launch(void* const* d_in, const int* in_sizes, int n_in, void* d_out, int out_size, void* d_ws, size_t ws_size, hipStream_t stream) {
    static int grid = 0;
    if (grid == 0) {
        if (n_in != 25 || out_size != (int)OUT_TOTAL || ws_size < WS_END) { fprintf(stderr, "kernel_launch: unexpected sizes n_in %d out %d ws %zu\n", n_in, out_size, ws_size); grid = -1; return; }
        int dev = 0, cus = 0, per_cu = 0;
        if (hipGetDevice(&dev) != hipSuccess || hipDeviceGetAttribute(&cus, hipDeviceAttributeMultiprocessorCount, dev) != hipSuccess) { grid = -1; return; }
        if (hipFuncSetAttribute((const void*)mk_fwd, hipFuncAttributeMaxDynamicSharedMemorySize, LDS_BYTES) != hipSuccess) { fprintf(stderr, "kernel_launch: hipFuncSetAttribute failed\n"); grid = -1; return; }
        if (hipOccupancyMaxActiveBlocksPerMultiprocessor(&per_cu, (const void*)mk_fwd, NWAVES * 64, LDS_BYTES) != hipSuccess || per_cu < 1) { fprintf(stderr, "kernel_launch: occupancy query says %d\n", per_cu); }
        (void)hipGetLastError();
        grid = cus;
    }
    if (grid < 0) return;
    if (hipMemsetAsync((char*)d_ws + WS_CTL, 0, CTL_ZERO_BYTES, stream) != hipSuccess) return;
    Args a{};
    for (int i = 0; i < 25; ++i) a.in[i] = (const float*)d_in[i];
    a.out = (float*)d_out; a.ws = (unsigned char*)d_ws;
#if MK_ONE_LAUNCH
    a.ph_lo = 0; a.ph_hi = NPHASE;
    hipLaunchKernelGGL(mk_fwd, dim3(grid), dim3(NWAVES * 64), LDS_BYTES, stream, a);
#else
    for (int p = 0; p < NPHASE; ++p) { a.ph_lo = p; a.ph_hi = p + 1; hipLaunchKernelGGL(mk_fwd, dim3(grid), dim3(NWAVES * 64), LDS_BYTES, stream, a); }
#endif
}
```

```cpp
#include <hip/hip_runtime.h>
#include <cstdio>
#include <cstdint>

#ifndef PROBE_DUP
#define PROBE_DUP -1
#endif
#ifndef MK_ONE_LAUNCH
#define MK_ONE_LAUNCH 1
#endif

constexpr int DM = 4096, SEQ = 4096, NB_P = 2, NB_S = 8, DSEQ = 32, PAST = 2048;
constexpr int MP = NB_P * SEQ;
constexpr int MS = NB_S * DSEQ;
constexpr int MT = MP + MS;
constexpr int MC = NB_S * PAST;
constexpr int ML = MT + MC;
constexpr int NH = 16, QLORA = 1024, KVLORA = 512, ROPE = 64, NOPE = 128, VD = 128, SBD = 128;
constexpr int INCOLS = 7744, N1 = 7936;
constexpr int DFF = 11008, NGU = 2 * DFF;
constexpr int NMOD = 6 * DM;
constexpr float EPS = 1e-6f;
constexpr int XPITCH = DM;
constexpr float LOG2E = 1.4426950408889634f;
constexpr float MLA_QS = 0.07216878364870322f * LOG2E;
constexpr float SB_QS = 0.08838834764831845f * LOG2E;
constexpr int GU_NF8 = 4;
constexpr int GU_KB16 = DM - 128 * GU_NF8, GU_NT16 = GU_KB16 / 64, GU_NT = GU_NT16 + GU_NF8;
constexpr float H8_SCALE = 8.0f, WGU_SCALE = 2048.0f;
constexpr float ACT_SCALE = 8.0f, WD_SCALE = 2048.0f;

constexpr size_t OUT_Y = 0, OUT_PLAT = 34603008, OUT_PKR = 38797312, OUT_PSBK = 39321600, OUT_PSBV = 56098816,
                 OUT_SLAT = 72876032, OUT_SKR = 73007104, OUT_SSBK = 73023488, OUT_SSBV = 73547776, OUT_TOTAL = 74072064;

constexpr size_t MiB = 1u << 20;
constexpr size_t WS_CTL = 0, CTL_ZERO_BYTES = 32 * 1024;
constexpr size_t WS_MOD = 1 * MiB;
constexpr size_t WS_COS = 2 * MiB, WS_SIN = 3 * MiB;
constexpr size_t WS_QSS = 4 * MiB;
constexpr size_t WS_KVSS = 5 * MiB;
constexpr size_t WS_OSS = 6 * MiB;
constexpr size_t WS_W1T = 8 * MiB;
constexpr size_t WS_WUQT = 72 * MiB;
constexpr size_t WS_WUKVT = 80 * MiB;
constexpr size_t WS_WOUTT = 84 * MiB;
constexpr size_t WS_WGUT = 116 * MiB;
constexpr size_t WS_WDT = 288 * MiB;
constexpr size_t WS_H = 376 * MiB;
constexpr size_t WS_A2A = 444 * MiB;
constexpr size_t WS_LATA = 462 * MiB;
constexpr size_t WS_KR = 488 * MiB;
constexpr size_t WS_KV = 492 * MiB;
constexpr size_t WS_QM = 688 * MiB;
constexpr size_t WS_SBQ = 738 * MiB, WS_SBK = 772 * MiB, WS_SBV = 806 * MiB;
constexpr size_t WS_O = 840 * MiB;
constexpr size_t WS_X1 = 908 * MiB;
constexpr size_t WS_X2 = 975 * MiB;
constexpr size_t WS_ACT = 1042 * MiB;
constexpr size_t WS_SLAB = 1222 * MiB;
constexpr size_t WS_ADAP = 1288 * MiB;
constexpr size_t WS_END = 1320 * MiB;
constexpr int CW_BAR = 4096;
constexpr int CW_QUEUE = 64;

#define GAS __attribute__((address_space(1)))
#define LAS __attribute__((address_space(3)))
typedef unsigned short bf16;
typedef unsigned v4u __attribute__((ext_vector_type(4)));
typedef unsigned v2u __attribute__((ext_vector_type(2)));
typedef float f32x4 __attribute__((ext_vector_type(4)));
typedef float f32x2 __attribute__((ext_vector_type(2)));
typedef float f32x16 __attribute__((ext_vector_type(16)));
typedef short bf16x8 __attribute__((ext_vector_type(8)));
typedef short s16x4 __attribute__((ext_vector_type(4)));
typedef __bf16 bf16x2_t __attribute__((ext_vector_type(2)));
#define LDS_WAIT() asm volatile("s_waitcnt lgkmcnt(0)" ::: "memory")
__device__ __forceinline__ unsigned pk2(float lo, float hi) { f32x2 v = {lo, hi}; bf16x2_t b = __builtin_convertvector(v, bf16x2_t); return __builtin_bit_cast(unsigned, b); }
__device__ __forceinline__ v2u pk4(f32x4 v) { v2u r; r.x = pk2(v[0], v[1]); r.y = pk2(v[2], v[3]); return r; }
__device__ __forceinline__ f32x4 up4(v2u w) { f32x4 r; r[0] = __uint_as_float(w.x << 16); r[1] = __uint_as_float(w.x & 0xffff0000u); r[2] = __uint_as_float(w.y << 16); r[3] = __uint_as_float(w.y & 0xffff0000u); return r; }
typedef _Float16 h16x4 __attribute__((ext_vector_type(4)));
__device__ __forceinline__ v2u pk4h(f32x4 v) { const h16x4 h = __builtin_convertvector(v, h16x4); return __builtin_bit_cast(v2u, h); }
__device__ __forceinline__ f32x4 up4h(v2u w) { const h16x4 h = __builtin_bit_cast(h16x4, w); return __builtin_convertvector(h, f32x4); }
__device__ __forceinline__ void up8h(v4u w, f32x4& a, f32x4& b) { v2u lo; lo.x = w.x; lo.y = w.y; v2u hi; hi.x = w.z; hi.y = w.w; a = up4h(lo); b = up4h(hi); }
__device__ __forceinline__ v4u pk8(f32x4 a, f32x4 b) { const v2u x = pk4(a), y = pk4(b); v4u o; o.x = x.x; o.y = x.y; o.z = y.x; o.w = y.y; return o; }
__device__ __forceinline__ unsigned pk4f8(f32x4 a, float sc) {
    const float r0 = __builtin_amdgcn_fmed3f(a[0] * sc, -448.0f, 448.0f), r1 = __builtin_amdgcn_fmed3f(a[1] * sc, -448.0f, 448.0f), r2 = __builtin_amdgcn_fmed3f(a[2] * sc, -448.0f, 448.0f), r3 = __builtin_amdgcn_fmed3f(a[3] * sc, -448.0f, 448.0f);
    int p = __builtin_amdgcn_cvt_pk_fp8_f32(r0, r1, 0, false); p = __builtin_amdgcn_cvt_pk_fp8_f32(r2, r3, p, true); return (unsigned)p; }
__device__ __forceinline__ float wave_sum(float v) {
#pragma unroll
    for (int o = 1; o < 64; o <<= 1) v += __shfl_xor(v, o);
    return v;
}
__device__ __forceinline__ int bidx_of(int row) { return row < MP ? (row >> 12) : 2 + ((row - MP) >> 5); }
__device__ __forceinline__ int pos_of(int row) { return row < MP ? (row & (SEQ - 1)) : PAST + ((row - MP) & 31); }

#define XB_TMO      128
#define XB_XCNT(j)  (256  + 64 * (j))
#define XB_XSUB(j)  (1280 + 64 * (j))
#define XB_XGEN(j)  (2304 + 64 * (j))
#define XB_TOP      3328
#define XB_TOPGEN   3392
#define XCD_BAR_WORDS 3456
#define XB_SPIN_CAP (1u << 18)
__device__ __forceinline__ unsigned xb_ld(unsigned* p)              { return __hip_atomic_load(p, __ATOMIC_RELAXED, __HIP_MEMORY_SCOPE_AGENT); }
__device__ __forceinline__ unsigned xb_add(unsigned* p, unsigned v) { return __hip_atomic_fetch_add(p, v, __ATOMIC_RELAXED, __HIP_MEMORY_SCOPE_AGENT); }
__device__ __forceinline__ unsigned xb_xcc_id() { return (unsigned)__builtin_amdgcn_s_getreg((3 << 11) | 20) & 0xFu; }
#define XB_SPIN(cond, bar) do { unsigned _sp = 0; while (cond) { __builtin_amdgcn_s_sleep(1); \
    if ((++_sp & 255u) == 0u) { if (xb_ld(&(bar)[XB_TMO])) break; if (_sp > XB_SPIN_CAP) { atomicAdd(&(bar)[XB_TMO], 1u); break; } } } } while (0)
struct XcdBarrier { unsigned* bar; unsigned x; volatile LAS unsigned* st; };
__device__ __forceinline__ XcdBarrier xcd_barrier_post(unsigned* bar, volatile LAS unsigned* st) {
    XcdBarrier b; b.bar = bar; b.x = xb_xcc_id(); b.st = st;
    if (threadIdx.x == 0) (void)xb_add(&bar[XB_XCNT(b.x)], 1u);
    return b;
}
__device__ __forceinline__ void xcd_barrier_complete(unsigned* bar, unsigned x, unsigned& nloc, unsigned& nx) {
    const unsigned G = gridDim.x * gridDim.y * gridDim.z;
    unsigned sum, cnt, mine, sp = 0u;
    for (;;) {
        sum = 0u; cnt = 0u; mine = 0u;
#pragma unroll
        for (unsigned j = 0; j < 16; ++j) { const unsigned c = xb_ld(&bar[XB_XCNT(j)]); sum += c; cnt += (c > 0u) ? 1u : 0u; mine = (j == x) ? c : mine; }
        if (sum == G) break;
        __builtin_amdgcn_s_sleep(1);
        if ((++sp & 255u) == 0u) { if (xb_ld(&bar[XB_TMO])) break; if (sp > XB_SPIN_CAP) { atomicAdd(&bar[XB_TMO], 1u); break; } }
    }
    nloc = mine > 0u ? mine : 1u; nx = cnt > 0u ? cnt : 1u;
}
__device__ __forceinline__ void xcd_barrier(const XcdBarrier& b) {
    asm volatile("s_waitcnt vmcnt(0)" ::: "memory");
    __syncthreads();
    if (threadIdx.x == 0) {
        unsigned* bar = b.bar;
        __builtin_amdgcn_s_waitcnt(0);
        unsigned nloc = b.st[0], nx = b.st[1];
        if (nloc == 0u) { xcd_barrier_complete(bar, b.x, nloc, nx); b.st[0] = nloc; b.st[1] = nx; }
        const unsigned old = xb_add(&bar[XB_XSUB(b.x)], 1u);
        const unsigned gen = old / nloc;
        if (old + 1u == (gen + 1u) * nloc) {
            __builtin_amdgcn_fence(__ATOMIC_RELEASE, "agent");
            asm volatile("s_waitcnt vmcnt(0)" ::: "memory");
            const unsigned og = xb_add(&bar[XB_TOP], 1u);
            const unsigned tg = og / nx;
            if (og + 1u == (tg + 1u) * nx) xb_add(&bar[XB_TOPGEN], 1u);
            else XB_SPIN(xb_ld(&bar[XB_TOPGEN]) == tg, bar);
            __builtin_amdgcn_fence(__ATOMIC_ACQUIRE, "agent");
            xb_add(&bar[XB_XGEN(b.x)], 1u);
            asm volatile("s_waitcnt vmcnt(0)" ::: "memory");
        } else {
            XB_SPIN(xb_ld(&bar[XB_XGEN(b.x)]) == gen, bar);
            __builtin_amdgcn_fence(__ATOMIC_ACQUIRE, "agent");
            asm volatile("s_waitcnt vmcnt(0)" ::: "memory");
        }
    }
    __syncthreads();
}

namespace pg8 {
#define PG8_LAS __attribute__((address_space(3)))
typedef unsigned short bf16_t;
typedef int v4i_t __attribute__((ext_vector_type(4)));
typedef int v8i_t __attribute__((ext_vector_type(8)));
constexpr int BM = 256, BK = 64, HALF = 128, HTB = HALF * BK * 2, STAGE_BYTES = 8 * HTB, NXCD = 8, WGM = 8;
__host__ __device__ __forceinline__ int lds_byte(int r, int c) { const int st = (r >> 4) * 2 + (c >> 5), rr = r & 15, cc = c & 31, ob = rr * 64 + cc * 2; return st * 1024 + (ob ^ (((ob >> 9) & 1) << 5)); }
__host__ __device__ __forceinline__ void stage_rc(int b, int& R, int& C) { const int st = b / 1024, sb = b % 1024, swz = sb ^ (((sb >> 9) & 1) << 5); R = (st >> 1) * 16 + swz / 64; C = (st & 1) * 32 + (swz % 64) / 2; }
__host__ __device__ __forceinline__ int perm32(int rho) { const int n = rho >> 4, i = rho & 15; return 8 * (i >> 2) + 4 * n + (i & 3); }
template <bool B> struct BoolTag { static constexpr bool value = B; };
struct Unit { int pm, pn, kt0, nt, split; };
struct Gemm { const bf16_t* A; const bf16_t* Bt; int M, N, K; };
struct StaticOrder {
    int nM, nN, nwg, G, c, ntf;
    __host__ __device__ void init(int M, int N, int G_, int c_, int K_) { nM = M / BM; nN = N / BM; nwg = nM * nN; G = G_; c = c_; ntf = K_ / BK; }
    __host__ __device__ __forceinline__ void tile_of(int L, int& pm, int& pn) const {
        int wgid = L; { const int q = nwg / NXCD, r = nwg % NXCD, xcd = wgid % NXCD, off = wgid / NXCD; wgid = (xcd < r ? xcd * (q + 1) : r * (q + 1) + (xcd - r) * q) + off; }
        const int nig = WGM * nN, gid = wgid / nig, fm = gid * WGM, gsz = (nM - fm) < WGM ? (nM - fm) : WGM;
        pm = fm + ((wgid % nig) % gsz); pn = (wgid % nig) / gsz;
    }
    __host__ __device__ __forceinline__ bool next(int i, Unit& u) const {
        const long L = (long)i * G + c; if (L >= nwg) return false;
        tile_of((int)L, u.pm, u.pn); u.kt0 = 0; u.nt = ntf; u.split = -1; return true;
    }
    __device__ __forceinline__ void a_ready(const Unit&) const {}
    __device__ __forceinline__ void done(const Unit&) const {}
};
struct TailSplitOrder {
    StaticOrder so; int pmS;
    __host__ __device__ void init(int M, int N, int G_, int c_, int K_, int pmS_) { so.init(M, N, G_, c_, K_); pmS = pmS_; }
    __host__ __device__ __forceinline__ bool next(int i, Unit& u) const {
        Unit a; a.pm = 0; a.pn = 0; a.kt0 = 0; a.nt = so.ntf; a.split = -1;
        const bool fa = so.next(i, a);
        const long L = (long)i * so.G + so.c - so.nwg; const bool fb = !fa && L >= 0 && L < 256;
        const int sp = (int)(L & 15), small = 2 * (so.ntf / 32), nb = (so.ntf - 16 * small) / 2;
        const int nt2 = sp < nb ? small + 2 : small, kt2 = sp < nb ? sp * (small + 2) : nb * (small + 2) + (sp - nb) * small;
        u.pm = fa ? a.pm : pmS; u.pn = fa ? a.pn : (int)(L >> 4); u.kt0 = fa ? 0 : kt2; u.nt = fa ? so.ntf : nt2; u.split = fa ? -1 : sp;
        return fa || fb;
    }
    __device__ __forceinline__ void a_ready(const Unit&) const {}
    __device__ __forceinline__ void done(const Unit&) const {}
};
template <class Epi, class Sched, bool ALIGN_EPI = false, bool SP2 = false>
__device__ __forceinline__ void gemm_phase(PG8_LAS unsigned char* lds, const Gemm g, const Sched& S, const Epi& E) {
    const int tid = threadIdx.x, wid = __builtin_amdgcn_readfirstlane(tid >> 6), lane = tid & 63, wr = wid >> 2, wc = wid & 3, fr = lane & 15, fq = lane >> 4;
    const int K = g.K;
    unsigned voffA[2], voffB[2];
#pragma unroll
    for (int i = 0; i < 2; ++i) { int R, C; stage_rc(tid * 16 + i * 8192, R, C); const int Rb = Epi::PERM ? ((R & ~31) + perm32(R & 31)) : R;
        voffA[i] = (unsigned)(R * K + C) * 2u; voffB[i] = (unsigned)(Rb * K + C) * 2u; }
    const size_t kstep = (size_t)(BK * 2);
    const size_t hstep = (size_t)HALF * K * 2;
    const size_t tstep = 2 * hstep;
    const unsigned ldsw = (unsigned)wid * 1024u;
    const int aoff = lds_byte(wr * 64 + fr, fq * 8), boff = lds_byte(wc * 32 + fr, fq * 8);
#define PG8_SA(b, h) (((b) * 2 + (h)) * HTB)
#define PG8_SB(b, h) ((4 + (b) * 2 + (h)) * HTB)
#define PG8_STAGE(bufoff, gbase, voff) do { _Pragma("unroll") for (int _i = 0; _i < 2; ++_i) \
        __builtin_amdgcn_global_load_lds((const unsigned*)((const char*)(gbase) + (voff)[_i]), (PG8_LAS unsigned*)(lds + (bufoff) + ldsw + _i * 8192), 16, 0, 0); } while (0)
#define PG8_LDA(dst, b, h) do { if constexpr (F8) { _Pragma("unroll") for (int m = 0; m < 4; ++m) dst##8[m] = PG8_CAT8(*(const PG8_LAS bf16x8*)(lds + PG8_SA(b, h) + aoff + m * 2048), *(const PG8_LAS bf16x8*)(lds + PG8_SA(b, h) + aoff + m * 2048 + 1024)); } \
        else { _Pragma("unroll") for (int m = 0; m < 4; ++m) _Pragma("unroll") for (int k = 0; k < 2; ++k) dst[m][k] = *(const PG8_LAS bf16x8*)(lds + PG8_SA(b, h) + aoff + m * 2048 + k * 1024); } } while (0)
#define PG8_LDB(dst, b, h) do { if constexpr (F8) { _Pragma("unroll") for (int n = 0; n < 2; ++n) dst##8[n] = PG8_CAT8(*(const PG8_LAS bf16x8*)(lds + PG8_SB(b, h) + boff + n * 2048), *(const PG8_LAS bf16x8*)(lds + PG8_SB(b, h) + boff + n * 2048 + 1024)); } \
        else { _Pragma("unroll") for (int n = 0; n < 2; ++n) _Pragma("unroll") for (int k = 0; k < 2; ++k) dst[n][k] = *(const PG8_LAS bf16x8*)(lds + PG8_SB(b, h) + boff + n * 2048 + k * 1024); } } while (0)
#define PG8_CAT8(x, y) __builtin_shufflevector(__builtin_bit_cast(v4i_t, (x)), __builtin_bit_cast(v4i_t, (y)), 0, 1, 2, 3, 4, 5, 6, 7)
#define PG8_MMA(ai, bj, At, Bt) do { __builtin_amdgcn_s_setprio(1); \
        if constexpr (F8) { _Pragma("unroll") for (int m = 0; m < 4; ++m) _Pragma("unroll") for (int n = 0; n < 2; ++n) \
            asm volatile("v_mfma_f32_16x16x128_f8f6f4 %0, %1, %2, %0" : "+v"(acc[ai][bj][m][n]) : "v"(Bt##8[n]), "v"(At##8[m])); }     \
        else { _Pragma("unroll") for (int m = 0; m < 4; ++m) _Pragma("unroll") for (int n = 0; n < 2; ++n) _Pragma("unroll") for (int k = 0; k < 2; ++k) \
            acc[ai][bj][m][n] = __builtin_amdgcn_mfma_f32_16x16x32_bf16(Bt[n][k], At[m][k], acc[ai][bj][m][n], 0, 0, 0); } \
        __builtin_amdgcn_s_setprio(0); } while (0)
#define PG8_WAIT_V(n) asm volatile("s_waitcnt vmcnt(" #n ")" ::: "memory")
#define PG8_WAIT_L(n) asm volatile("s_waitcnt lgkmcnt(" #n ")" ::: "memory")
#define PG8_BAR __builtin_amdgcn_s_barrier()
#define PG8_SCHED __builtin_amdgcn_sched_barrier(0)
    Unit cur, nxt; int ui = 0;
    if (!S.next(0, cur)) return;
    f32x4 acc[2][2][4][2];
#pragma unroll
    for (int a = 0; a < 2; ++a)
#pragma unroll
        for (int b = 0; b < 2; ++b)
#pragma unroll
            for (int m = 0; m < 4; ++m)
#pragma unroll
                for (int n = 0; n < 2; ++n) acc[a][b][m][n] = (f32x4){0.f, 0.f, 0.f, 0.f};
    bf16x8 At[4][2], B0[2][2], B1[2][2]; v8i_t At8[4], B08[2], B18[2];
    const char* cA = (const char*)g.A + (size_t)cur.pm * tstep + (size_t)cur.kt0 * kstep; const char* cB = (const char*)g.Bt + (size_t)cur.pn * tstep + (size_t)cur.kt0 * kstep;
    S.a_ready(cur);
    if constexpr (SP2) {
        PG8_STAGE(PG8_SB(0, 0), cB, voffB); PG8_STAGE(PG8_SB(0, 1), cB + hstep, voffB); PG8_STAGE(PG8_SA(0, 0), cA, voffA); PG8_STAGE(PG8_SA(0, 1), cA + hstep, voffA);
        if (wr == 1) PG8_BAR;
        PG8_WAIT_V(2); PG8_BAR;
        PG8_STAGE(PG8_SB(1, 0), cB + kstep, voffB); PG8_STAGE(PG8_SA(1, 0), cA + kstep, voffA); PG8_STAGE(PG8_SB(1, 1), cB + hstep + kstep, voffB);
        PG8_WAIT_V(6); PG8_BAR;
    } else {
        PG8_STAGE(PG8_SB(0, 0), cB, voffB); PG8_STAGE(PG8_SA(0, 0), cA, voffA); PG8_STAGE(PG8_SB(0, 1), cB + hstep, voffB); PG8_STAGE(PG8_SA(0, 1), cA + hstep, voffA);
        if (wr == 1) PG8_BAR;
        PG8_WAIT_V(4); PG8_BAR;
        PG8_STAGE(PG8_SB(1, 0), cB + kstep, voffB); PG8_STAGE(PG8_SA(1, 0), cA + kstep, voffA); PG8_STAGE(PG8_SB(1, 1), cB + hstep + kstep, voffB);
        PG8_WAIT_V(6); PG8_BAR;
    }
    for (;;) {
        const bool has_next = S.next(ui + 1, nxt);
        const char* nA = has_next ? (const char*)g.A + (size_t)nxt.pm * tstep + (size_t)nxt.kt0 * kstep : cA; const char* nB = has_next ? (const char*)g.Bt + (size_t)nxt.pn * tstep + (size_t)nxt.kt0 * kstep : cB;
        const int nt = cur.nt;
        auto kloop = [&](auto f8tag, const int t0, const int t1) __attribute__((always_inline)) {
        constexpr bool F8 = decltype(f8tag)::value;
        for (int t = t0; t < t1; t += 2) {
            const bool last = (t == nt - 2);
            const char* a1 = cA + (size_t)(t + 1) * kstep;
            const char* a2 = last ? nA : cA + (size_t)(t + 2) * kstep; const char* b2 = last ? nB : cB + (size_t)(t + 2) * kstep;
            const char* a3 = a2 + kstep; const char* b3 = b2 + kstep;
            if (last && has_next) S.a_ready(nxt);
            if constexpr (SP2) {
            PG8_LDB(B0, 0, 0); PG8_LDB(B1, 0, 1); PG8_SCHED; PG8_LDA(At, 0, 0); PG8_STAGE(PG8_SA(1, 1), a1 + hstep, voffA);
            PG8_WAIT_V(8); PG8_WAIT_L(0); PG8_BAR; PG8_MMA(0, 0, At, B0); PG8_MMA(0, 1, At, B1); PG8_BAR; PG8_SCHED;
            PG8_LDA(At, 0, 1); PG8_STAGE(PG8_SB(0, 0), b2, voffB); PG8_STAGE(PG8_SB(0, 1), b2 + hstep, voffB); PG8_STAGE(PG8_SA(0, 0), a2, voffA);
            PG8_WAIT_V(8); PG8_WAIT_L(0); PG8_BAR; PG8_MMA(1, 0, At, B0); PG8_MMA(1, 1, At, B1); PG8_BAR; PG8_SCHED;
            PG8_LDB(B0, 1, 0); PG8_LDB(B1, 1, 1); PG8_SCHED; PG8_LDA(At, 1, 0); PG8_STAGE(PG8_SA(0, 1), a2 + hstep, voffA);
            PG8_WAIT_V(8); PG8_WAIT_L(0); PG8_BAR; PG8_MMA(0, 0, At, B0); PG8_MMA(0, 1, At, B1); PG8_BAR; PG8_SCHED;
            PG8_LDA(At, 1, 1); PG8_STAGE(PG8_SB(1, 0), b3, voffB); PG8_STAGE(PG8_SB(1, 1), b3 + hstep, voffB); PG8_STAGE(PG8_SA(1, 0), a3, voffA);
            PG8_WAIT_V(8); PG8_WAIT_L(0); PG8_BAR; PG8_MMA(1, 0, At, B0); PG8_MMA(1, 1, At, B1); PG8_BAR; PG8_SCHED;
            } else {
            PG8_LDB(B0, 0, 0); PG8_SCHED; PG8_LDA(At, 0, 0); PG8_STAGE(PG8_SA(1, 1), a1 + hstep, voffA);
            PG8_WAIT_L(8); PG8_BAR; PG8_WAIT_L(0); PG8_MMA(0, 0, At, B0); PG8_BAR; PG8_SCHED;
            PG8_LDB(B1, 0, 1); PG8_STAGE(PG8_SB(0, 0), b2, voffB);
            PG8_BAR; PG8_WAIT_L(0); PG8_MMA(0, 1, At, B1); PG8_BAR;
            PG8_LDA(At, 0, 1); PG8_STAGE(PG8_SA(0, 0), a2, voffA);
            PG8_BAR; PG8_WAIT_L(0); PG8_MMA(1, 0, At, B0); PG8_BAR; PG8_SCHED;
            PG8_STAGE(PG8_SB(0, 1), b2 + hstep, voffB);
            PG8_WAIT_V(6); PG8_BAR; PG8_MMA(1, 1, At, B1); PG8_BAR;
            PG8_LDB(B0, 1, 0); PG8_SCHED; PG8_LDA(At, 1, 0); PG8_STAGE(PG8_SA(0, 1), a2 + hstep, voffA);
            PG8_WAIT_L(8); PG8_BAR; PG8_WAIT_L(0); PG8_MMA(0, 0, At, B0); PG8_BAR; PG8_SCHED;
            PG8_LDB(B1, 1, 1); PG8_STAGE(PG8_SB(1, 0), b3, voffB);
            PG8_BAR; PG8_WAIT_L(0); PG8_MMA(0, 1, At, B1); PG8_BAR;
            PG8_LDA(At, 1, 1); PG8_STAGE(PG8_SA(1, 0), a3, voffA);
            PG8_BAR; PG8_WAIT_L(0); PG8_MMA(1, 0, At, B0); PG8_BAR; PG8_SCHED;
            PG8_STAGE(PG8_SB(1, 1), b3 + hstep, voffB);
            PG8_WAIT_V(6); PG8_BAR; PG8_MMA(1, 1, At, B1); PG8_BAR;
            }
        } };
        if constexpr (Epi::MIXNT16 > 0) {
            kloop(BoolTag<false>{}, 0, Epi::MIXNT16);
#pragma unroll
            for (int a = 0; a < 2; ++a)
#pragma unroll
                for (int b = 0; b < 2; ++b)
#pragma unroll
                    for (int m = 0; m < 4; ++m)
#pragma unroll
                        for (int n = 0; n < 2; ++n) acc[a][b][m][n] *= Epi::MIXSCALE;
            PG8_SCHED;
            kloop(BoolTag<true>{}, Epi::MIXNT16, nt);
        } else kloop(BoolTag<Epi::FP8>{}, 0, nt);
        if constexpr (Epi::FP8 || Epi::MIXNT16 > 0) asm volatile("s_nop 15\n\ts_nop 15" ::: "memory");
        if constexpr (ALIGN_EPI) { if (wr == 0) PG8_BAR; }
        E(acc, cur, wr, wc, fr, fq); S.done(cur);
        if (!has_next) break;
#pragma unroll
        for (int a = 0; a < 2; ++a)
#pragma unroll
            for (int b = 0; b < 2; ++b)
#pragma unroll
                for (int m = 0; m < 4; ++m)
#pragma unroll
                    for (int n = 0; n < 2; ++n) acc[a][b][m][n] = (f32x4){0.f, 0.f, 0.f, 0.f};
        cur = nxt; cA = nA; cB = nB; ++ui;
        if constexpr (ALIGN_EPI) { if (wr == 1) PG8_BAR; }
    }
    PG8_WAIT_V(0);
    if constexpr (!ALIGN_EPI) { if (wr == 0) PG8_BAR; }
    PG8_BAR;
#undef PG8_SA
#undef PG8_SB
#undef PG8_STAGE
#undef PG8_LDA
#undef PG8_LDB
#undef PG8_MMA
#undef PG8_CAT8
#undef PG8_WAIT_V
#undef PG8_WAIT_L
#undef PG8_BAR
#undef PG8_SCHED
}
}
#define PG8_SP2 true
#define PG8_ALIGN true

constexpr int NWAVES = 8;
constexpr int RING_OFF = 0, RING_BYTES = 131072;
constexpr int LDSCTL_OFF = RING_BYTES, MISC_OFF = LDSCTL_OFF + 320;
constexpr int LDS_BYTES = 147456;

struct Args { const float* in[25]; float* out; unsigned char* ws; int ph_lo, ph_hi; };

struct Frame {
    LAS unsigned char* lds;
    volatile LAS unsigned* MISC;
    unsigned* ctl;
    int tid, lane, wave, G, gw, NGW;
    float* out; unsigned char* ws;
};
#define WSP(T, off) ((T*)(F.ws + (off)))

struct Epi1 {
    static constexpr bool FP8 = false; static constexpr int MIXNT16 = 0;
    static constexpr bool PERM = false;
    const float *g_q, *g_kv; unsigned char* ws; float* out;
    __device__ __forceinline__ void operator()(const f32x4 (&acc)[2][2][4][2], const pg8::Unit& u, int wr, int wc, int fr, int fq) const {
        const int pn = u.pn; const bool samp = (u.pm >= MP / 256);
        const int row0 = u.pm * 256 + wr * 64 + fr;
        const int cw = wc * 32 + 4 * fq;
        if (pn < 4) {
            bf16* A2A = (bf16*)(ws + WS_A2A); float* QSS = (float*)(ws + WS_QSS);
            f32x4 gv[2][2];
#pragma unroll
            for (int bj = 0; bj < 2; ++bj)
#pragma unroll
                for (int n = 0; n < 2; ++n) gv[bj][n] = *(const f32x4*)(g_q + pn * 256 + bj * 128 + n * 16 + cw);
#pragma unroll
            for (int ai = 0; ai < 2; ++ai)
#pragma unroll
                for (int m = 0; m < 4; ++m) {
                    const int row = row0 + ai * 128 + m * 16; float ss = 0.f;
#pragma unroll
                    for (int bj = 0; bj < 2; ++bj)
#pragma unroll
                        for (int n = 0; n < 2; ++n) { const f32x4 v = acc[ai][bj][m][n]; ss += (v[0] * v[0] + v[1] * v[1]) + (v[2] * v[2] + v[3] * v[3]);
                            *(v2u*)(A2A + (size_t)row * QLORA + pn * 256 + bj * 128 + n * 16 + cw) = pk4(v * gv[bj][n]); }
                    ss += __shfl_xor(ss, 16); ss += __shfl_xor(ss, 32);
                    if (fq == 0) QSS[row * 16 + pn * 4 + wc] = ss;
                }
        } else if (pn < 6) {
            bf16* LATA = (bf16*)(ws + WS_LATA); float* KVSS = (float*)(ws + WS_KVSS);
            const int ct = (pn - 4) * 256;
            f32x4 gv[2][2];
#pragma unroll
            for (int bj = 0; bj < 2; ++bj)
#pragma unroll
                for (int n = 0; n < 2; ++n) gv[bj][n] = *(const f32x4*)(g_kv + ct + bj * 128 + n * 16 + cw);
            float* of = out + (samp ? OUT_SLAT - (size_t)MP * KVLORA : OUT_PLAT);
#pragma unroll
            for (int ai = 0; ai < 2; ++ai)
#pragma unroll
                for (int m = 0; m < 4; ++m) {
                    const int row = row0 + ai * 128 + m * 16; float ss = 0.f;
#pragma unroll
                    for (int bj = 0; bj < 2; ++bj)
#pragma unroll
                        for (int n = 0; n < 2; ++n) { const f32x4 v = acc[ai][bj][m][n]; ss += (v[0] * v[0] + v[1] * v[1]) + (v[2] * v[2] + v[3] * v[3]);
                            const int col = ct + bj * 128 + n * 16 + cw;
                            *(f32x4*)(of + (size_t)row * KVLORA + col) = v;
                            *(v2u*)(LATA + (size_t)row * KVLORA + col) = pk4(v * gv[bj][n]); }
                    ss += __shfl_xor(ss, 16); ss += __shfl_xor(ss, 32);
                    if (fq == 0) KVSS[row * 8 + (pn - 4) * 4 + wc] = ss;
                }
        } else if (pn < 14) {
            bf16* SBQ = (bf16*)(ws + WS_SBQ);
            const int ct = (pn - 6) * 256;
#pragma unroll
            for (int ai = 0; ai < 2; ++ai)
#pragma unroll
                for (int m = 0; m < 4; ++m) {
                    const int row = row0 + ai * 128 + m * 16;
#pragma unroll
                    for (int bj = 0; bj < 2; ++bj)
#pragma unroll
                        for (int n = 0; n < 2; ++n) *(v2u*)(SBQ + (size_t)row * 2048 + ct + bj * 128 + n * 16 + cw) = pk4(acc[ai][bj][m][n] * SB_QS);
                }
        } else if (pn < 30) {
            const bool isk = pn < 22; const int ct = (pn - (isk ? 14 : 22)) * 256;
            bf16* ob = (bf16*)(ws + (isk ? WS_SBK : WS_SBV));
            float* of = out + (samp ? (isk ? OUT_SSBK : OUT_SSBV) - (size_t)MP * 2048 : (isk ? OUT_PSBK : OUT_PSBV));
#pragma unroll
            for (int ai = 0; ai < 2; ++ai)
#pragma unroll
                for (int m = 0; m < 4; ++m) {
                    const int row = row0 + ai * 128 + m * 16;
#pragma unroll
                    for (int bj = 0; bj < 2; ++bj)
#pragma unroll
                        for (int n = 0; n < 2; ++n) { const f32x4 v = acc[ai][bj][m][n]; const int col = ct + bj * 128 + n * 16 + cw;
                            __builtin_nontemporal_store(v, (f32x4*)(of + (size_t)row * 2048 + col));
                            *(v2u*)(ob + (size_t)row * 2048 + col) = pk4(v); }
                }
        } else {
            if (wc < 2) {
                const float* cosT = (const float*)(ws + WS_COS); const float* sinT = (const float*)(ws + WS_SIN); bf16* KR = (bf16*)(ws + WS_KR);
                const int i0 = 16 * wc + 4 * fq; float* of = out + (samp ? OUT_SKR - (size_t)MP * ROPE : OUT_PKR);
#pragma unroll
                for (int ai = 0; ai < 2; ++ai)
#pragma unroll
                    for (int m = 0; m < 4; ++m) {
                        const int row = row0 + ai * 128 + m * 16; const int pos = pos_of(row);
                        const f32x4 cs = *(const f32x4*)(cosT + pos * 32 + i0), sn = *(const f32x4*)(sinT + pos * 32 + i0);
                        const f32x4 x1 = acc[ai][0][m][0], x2 = acc[ai][0][m][1];
                        const f32x4 o1 = x1 * cs - x2 * sn, o2 = x2 * cs + x1 * sn;
                        *(f32x4*)(of + (size_t)row * ROPE + i0) = o1; *(f32x4*)(of + (size_t)row * ROPE + 32 + i0) = o2;
                        *(v2u*)(KR + (size_t)row * ROPE + i0) = pk4(o1); *(v2u*)(KR + (size_t)row * ROPE + 32 + i0) = pk4(o2);
                    }
            }
        }
    }
};
struct Epi2a {
    static constexpr bool FP8 = false; static constexpr int MIXNT16 = 0;
    static constexpr bool PERM = false;
    const float *QSS, *cosT, *sinT; bf16* QM;
    __device__ __forceinline__ void operator()(const f32x4 (&acc)[2][2][4][2], const pg8::Unit& u, int wr, int wc, int fr, int fq) const {
        const int pn = u.pn; const int row0 = u.pm * 256 + wr * 64 + fr; const int cw = wc * 32 + 4 * fq;
#pragma unroll
        for (int ai = 0; ai < 2; ++ai)
#pragma unroll
            for (int m = 0; m < 4; ++m) {
                const int row = row0 + ai * 128 + m * 16;
                float ss = 0.f; const f32x4* sp = (const f32x4*)(QSS + row * 16);
#pragma unroll
                for (int j = 0; j < 4; ++j) { const f32x4 t = sp[j]; ss += (t[0] + t[1]) + (t[2] + t[3]); }
                const float sc = (1.0f / sqrtf(ss * (1.0f / QLORA) + EPS)) * MLA_QS;
                if (pn < 8) {
#pragma unroll
                    for (int bj = 0; bj < 2; ++bj)
#pragma unroll
                        for (int n = 0; n < 2; ++n) { const int col = pn * 256 + bj * 128 + n * 16 + cw; const int head = col >> 7, d = col & 127;
                            *(v2u*)(QM + (size_t)row * 3072 + head * 192 + d) = pk4(acc[ai][bj][m][n] * sc); }
                } else {
                    const int pos = pos_of(row); const int i0 = 16 * (wc & 1) + 4 * fq;
                    const f32x4 cs = *(const f32x4*)(cosT + pos * 32 + i0), sn = *(const f32x4*)(sinT + pos * 32 + i0);
#pragma unroll
                    for (int bj = 0; bj < 2; ++bj) { const int head = 4 * (pn - 8) + 2 * bj + (wc >> 1);
                        const f32x4 x1 = acc[ai][bj][m][0] * sc, x2 = acc[ai][bj][m][1] * sc;
                        const f32x4 o1 = x1 * cs - x2 * sn, o2 = x2 * cs + x1 * sn;
                        *(v2u*)(QM + (size_t)row * 3072 + head * 192 + 128 + i0) = pk4(o1); *(v2u*)(QM + (size_t)row * 3072 + head * 192 + 160 + i0) = pk4(o2); }
                }
            }
    }
};
struct Epi2b {
    static constexpr bool FP8 = false; static constexpr int MIXNT16 = 0;
    static constexpr bool PERM = false;
    const float* KVSS; bf16* KV; int rbase;
    __device__ __forceinline__ void operator()(const f32x4 (&acc)[2][2][4][2], const pg8::Unit& u, int wr, int wc, int fr, int fq) const {
        const int row0 = rbase + u.pm * 256 + wr * 64 + fr; const int cw = u.pn * 256 + wc * 32 + 4 * fq;
#pragma unroll
        for (int ai = 0; ai < 2; ++ai)
#pragma unroll
            for (int m = 0; m < 4; ++m) {
                const int row = row0 + ai * 128 + m * 16; float sc = 1.0f;
                if (row < MT) { const f32x4* sp = (const f32x4*)(KVSS + row * 8); const f32x4 a = sp[0], b = sp[1];
                    sc = 1.0f / sqrtf(((a[0] + a[1]) + (a[2] + a[3]) + (b[0] + b[1]) + (b[2] + b[3])) * (1.0f / KVLORA) + EPS); }
#pragma unroll
                for (int bj = 0; bj < 2; ++bj)
#pragma unroll
                    for (int n = 0; n < 2; ++n) *(v2u*)(KV + (size_t)row * 4096 + cw + bj * 128 + n * 16) = pk4(acc[ai][bj][m][n] * sc);
            }
    }
};
template <bool F8, bool BASE16> struct EpiRes {
    static constexpr bool PERM = false, FP8 = F8; static constexpr int MIXNT16 = 0;
    const void* base_p; const float* gate; bf16* out; bf16* slab; float oscale;
    __device__ __forceinline__ void operator()(const f32x4 (&acc)[2][2][4][2], const pg8::Unit& u, int wr, int wc, int fr, int fq) const {
        const int row0 = u.pm * 256 + wr * 64 + fr; const int cw = u.pn * 256 + wc * 32 + 4 * fq;
        if (u.split >= 0) {
            bf16* sp = slab + (size_t)u.split * MS * DM + (size_t)(wr * 64 + fr) * DM + cw;
#pragma unroll
            for (int ai = 0; ai < 2; ++ai)
#pragma unroll
                for (int m = 0; m < 4; ++m)
#pragma unroll
                    for (int bj = 0; bj < 2; ++bj)
#pragma unroll
                        for (int n = 0; n < 2; ++n) *(v2u*)(sp + (size_t)(ai * 128 + m * 16) * DM + bj * 128 + n * 16) = pk4h(acc[ai][bj][m][n] * oscale);
            return;
        }
        const int b = u.pm >> 4;
#pragma unroll
        for (int ai = 0; ai < 2; ++ai)
#pragma unroll
            for (int m = 0; m < 4; ++m) {
                const int row = row0 + ai * 128 + m * 16;
#pragma unroll
                for (int bj = 0; bj < 2; ++bj)
#pragma unroll
                    for (int n = 0; n < 2; ++n) { const int col = cw + bj * 128 + n * 16;
                        const f32x4 gt = *(const f32x4*)(gate + (size_t)b * NMOD + col);
                        const f32x4 bs = BASE16 ? up4h(*(const v2u*)((const bf16*)base_p + (size_t)row * DM + col)) : *(const f32x4*)((const float*)base_p + (size_t)row * DM + col);
                        *(v2u*)(out + (size_t)row * DM + col) = pk4h(bs + gt * (acc[ai][bj][m][n] * oscale)); }
            }
    }
};
struct EpiGU {
    static constexpr bool FP8 = false; static constexpr int MIXNT16 = GU_NT16;
    static constexpr float MIXSCALE = H8_SCALE * WGU_SCALE;
    static constexpr bool PERM = true;
    unsigned char* ACT8; float* slab;
    __device__ __forceinline__ void operator()(const f32x4 (&acc)[2][2][4][2], const pg8::Unit& u, int wr, int wc, int fr, int fq) const {
        if (u.split >= 0) {
            float* sp = slab + (size_t)u.split * 65536 + (size_t)(wr * 64 + fr) * 256 + wc * 32 + 8 * fq;
#pragma unroll
            for (int ai = 0; ai < 2; ++ai)
#pragma unroll
                for (int m = 0; m < 4; ++m)
#pragma unroll
                    for (int bj = 0; bj < 2; ++bj)
#pragma unroll
                        for (int n = 0; n < 2; ++n) *(f32x4*)(sp + (size_t)(ai * 128 + m * 16) * 256 + bj * 128 + 4 * n) = acc[ai][bj][m][n];
            return;
        }
        const int row0 = u.pm * 256 + wr * 64 + fr; const int col = u.pn * 128 + wc * 32 + 8 * fq;
#pragma unroll
        for (int ai = 0; ai < 2; ++ai)
#pragma unroll
            for (int m = 0; m < 4; ++m) {
                const int row = row0 + ai * 128 + m * 16; v2u w;
#pragma unroll
                for (int n = 0; n < 2; ++n) { const f32x4 g = acc[ai][0][m][n], up = acc[ai][1][m][n]; f32x4 r;
#pragma unroll
                    for (int e = 0; e < 4; ++e) { const float a = g[e] * up[e] * __builtin_amdgcn_rcpf(1.0f + __builtin_amdgcn_exp2f(-g[e] * (LOG2E / MIXSCALE))) * (ACT_SCALE / (MIXSCALE * MIXSCALE)); r[e] = __builtin_amdgcn_fmed3f(a, -448.0f, 448.0f); }
                    int p = __builtin_amdgcn_cvt_pk_fp8_f32(r[0], r[1], 0, false); p = __builtin_amdgcn_cvt_pk_fp8_f32(r[2], r[3], p, true);
                    if (n == 0) w.x = (unsigned)p; else w.y = (unsigned)p; }
                *(v2u*)(ACT8 + (size_t)row * DFF + col) = w;
            }
    }
};

__device__ __forceinline__ void transpose_item(const float* W, int Nsrc, bf16* WT, int K, int k0, int dst_n0, int src_col, LAS float* scr, int lane) {
    const int kh = lane >> 5, c = lane & 31;
    {
        const unsigned off0 = ((unsigned)(k0 + kh) * (unsigned)Nsrc + (unsigned)(src_col >= 0 ? src_col : 0)) * 4u, step = 8u * (unsigned)Nsrc;
        float v[32];
#pragma unroll
        for (int i = 0; i < 32; ++i) v[i] = __builtin_nontemporal_load((const float*)((const char*)W + (off0 + (unsigned)i * step)));
#pragma unroll
        for (int i = 0; i < 32; ++i) scr[(2 * i + kh) * 33 + c] = src_col >= 0 ? v[i] : 0.f;
    }
    LDS_WAIT(); asm volatile("" ::: "memory");
    const int ch = lane & 7;
#pragma unroll
    for (int j = 0; j < 4; ++j) { const int n = (lane >> 3) + 8 * j; const LAS float* s = scr + (8 * ch) * 33 + n;
        v4u o; o.x = pk2(s[0 * 33], s[1 * 33]); o.y = pk2(s[2 * 33], s[3 * 33]); o.z = pk2(s[4 * 33], s[5 * 33]); o.w = pk2(s[6 * 33], s[7 * 33]);
        *(v4u*)(WT + (size_t)(dst_n0 + n) * K + k0 + 8 * ch) = o; }
    LDS_WAIT(); asm volatile("" ::: "memory");
}
__device__ __forceinline__ void transpose_item_fp8(const float* W, int Nsrc, unsigned char* WT8, int K, int k0, int dst_n0, int src_col, float scale, LAS float* scr, int lane) {
    const int kh = lane >> 5, c = lane & 31;
    {
        const unsigned off0 = ((unsigned)(k0 + kh) * (unsigned)Nsrc + (unsigned)src_col) * 4u, step = 8u * (unsigned)Nsrc;
        float v[32];
#pragma unroll
        for (int i = 0; i < 32; ++i) v[i] = __builtin_nontemporal_load((const float*)((const char*)W + (off0 + (unsigned)i * step)));
#pragma unroll
        for (int i = 0; i < 32; ++i) scr[(2 * i + kh) * 33 + c] = v[i];
    }
    LDS_WAIT(); asm volatile("" ::: "memory");
    const int n = lane & 31, hf = lane >> 5;
    const LAS float* s = scr + (32 * hf) * 33 + n;
#pragma unroll
    for (int q = 0; q < 2; ++q) { v4u o;
#pragma unroll
        for (int d = 0; d < 4; ++d) { float f[4];
#pragma unroll
            for (int e = 0; e < 4; ++e) f[e] = __builtin_amdgcn_fmed3f(s[(16 * q + 4 * d + e) * 33] * scale, -448.0f, 448.0f);
            int p = __builtin_amdgcn_cvt_pk_fp8_f32(f[0], f[1], 0, false); p = __builtin_amdgcn_cvt_pk_fp8_f32(f[2], f[3], p, true); o[d] = (unsigned)p; }
        *(v4u*)(WT8 + (size_t)(dst_n0 + n) * K + k0 + 32 * hf + 16 * q) = o; }
    LDS_WAIT(); asm volatile("" ::: "memory");
}
__device__ __forceinline__ int rope_dim_of(int v) { return 32 * ((v >> 4) & 1) + 16 * (v >> 5) + (v & 15); }

__device__ __forceinline__ void adaln_unit(Frame& F, const Args& A, int cb, int ks) {
    const float* w_ada = A.in[8]; const float* c_p = A.in[6]; const float* c_s = A.in[7];
    float* P = WSP(float, WS_ADAP);
    LAS float* sc = (LAS float*)(F.lds + RING_OFF);
    LAS float* red = (LAS float*)(F.lds + RING_OFF + 8192);
    const int col4 = F.tid & 255, rh = F.tid >> 8;
    __syncthreads();
    for (int idx = F.tid; idx < 1280; idx += 512) { const int b = idx >> 7, kl = idx & 127; const int k = 128 * ks + kl;
        const float c = b < 2 ? c_p[b * DM + k] : c_s[(b - 2) * DM + k]; sc[kl * 10 + b] = c / (1.0f + expf(-c)); }
    __syncthreads();
    f32x4 acc[10];
#pragma unroll
    for (int b = 0; b < 10; ++b) acc[b] = (f32x4){0.f, 0.f, 0.f, 0.f};
    const float* wp = w_ada + (size_t)(128 * ks + rh) * NMOD + cb * 1024 + 4 * col4;
    for (int i0 = 0; i0 < 64; i0 += 16) {
        f32x4 wv[16];
#pragma unroll
        for (int u2 = 0; u2 < 16; ++u2) wv[u2] = __builtin_nontemporal_load((const f32x4*)(wp + (size_t)(2 * (i0 + u2)) * NMOD));
        asm volatile("" ::: "memory");
#pragma unroll
        for (int u2 = 0; u2 < 16; ++u2) {
            const LAS f32x2* sp = (const LAS f32x2*)(sc + (2 * (i0 + u2) + rh) * 10);
#pragma unroll
            for (int b2 = 0; b2 < 5; ++b2) { const f32x2 s = sp[b2]; acc[2 * b2] += wv[u2] * s[0]; acc[2 * b2 + 1] += wv[u2] * s[1]; }
        }
    }
    if (rh == 1) {
#pragma unroll
        for (int b = 0; b < 10; ++b) *(LAS f32x4*)(red + b * 1024 + 4 * col4) = acc[b];
    }
    __syncthreads();
    if (rh == 0) {
#pragma unroll
        for (int b = 0; b < 10; ++b) *(f32x4*)(P + ((size_t)ks * 10 + b) * NMOD + cb * 1024 + 4 * col4) = acc[b] + *(const LAS f32x4*)(red + b * 1024 + 4 * col4);
    }
    __syncthreads();
}
__device__ __forceinline__ void adaln_reduce(Frame& F, const Args& A, int c_lo, int c_hi) {
    const float* P = WSP(float, WS_ADAP); const float* b_ada = A.in[9]; float* MOD = WSP(float, WS_MOD);
    const int w4 = (c_hi - c_lo) / 4;
    for (int idx = blockIdx.x * 512 + F.tid; idx < 10 * w4; idx += F.G * 512) { const int b = idx / w4, c = c_lo + 4 * (idx % w4);
        f32x4 a = *(const f32x4*)(b_ada + c);
#pragma unroll 8
        for (int ks = 0; ks < 32; ++ks) a += *(const f32x4*)(P + ((size_t)ks * 10 + b) * NMOD + c);
        *(f32x4*)(MOD + (size_t)b * NMOD + c) = a; }
}
constexpr int I_1 = (DM / 64) * (N1 / 32), I_UQ = (QLORA / 64) * (3072 / 32), I_UKV = (KVLORA / 64) * (4096 / 32), I_O = (DM / 64) * (DM / 32),
              I_GU = (DM / 64) * (NGU / 32), I_D = (DFF / 64) * (DM / 32);
constexpr int I_EARLY = I_1 + I_UQ + I_UKV, NITEMS = I_EARLY + I_O + I_GU + I_D;
__device__ __forceinline__ void transpose_one(Frame& F, const Args& A, int it, LAS float* scr) {
    const int c = F.lane & 31; int r = it;
    if (r < I_1) { const int nblk = N1 / 32, kb = r / nblk, nb = r % nblk; const int n = 32 * nb + c; int src;
        if (n < 1536) src = n; else if (n < 7680) src = n + 64; else { const int v = n - 7680; src = v < 64 ? 1536 + rope_dim_of(v) : -1; }
        transpose_item(A.in[12], INCOLS, WSP(bf16, WS_W1T), DM, 64 * kb, 32 * nb, src, scr, F.lane); return; } r -= I_1;
    if (r < I_UQ) { const int nblk = 3072 / 32, kb = r / nblk, nb = r % nblk; const int n = 32 * nb + c; int src;
        if (n < 2048) src = (n >> 7) * 192 + (n & 127); else { const int cc = n - 2048; src = (cc >> 6) * 192 + 128 + rope_dim_of(cc & 63); }
        transpose_item(A.in[15], 3072, WSP(bf16, WS_WUQT), QLORA, 64 * kb, 32 * nb, src, scr, F.lane); return; } r -= I_UQ;
    if (r < I_UKV) { const int nblk = 4096 / 32, kb = r / nblk, nb = r % nblk; const int n = 32 * nb + c;
        transpose_item(n < 2048 ? A.in[16] : A.in[17], 2048, WSP(bf16, WS_WUKVT), KVLORA, 64 * kb, 32 * nb, n & 2047, scr, F.lane); return; } r -= I_UKV;
    if (r < I_O) { const int nblk = DM / 32, kb = r / nblk, nb = r % nblk;
        transpose_item(A.in[20], DM, WSP(bf16, WS_WOUTT), DM, 64 * kb, 32 * nb, 32 * nb + c, scr, F.lane); return; } r -= I_O;
    if (r < I_GU) { const int nblk = NGU / 32, kb = r / nblk, nb = r % nblk; const int n = 32 * nb + c; const int pn = n >> 8, cc = n & 255;
        if (64 * kb >= GU_KB16) transpose_item_fp8(cc < 128 ? A.in[21] : A.in[22], DFF, WSP(unsigned char, WS_WGUT) + GU_KB16, 2 * DM, 64 * kb, 32 * nb, pn * 128 + (cc & 127), WGU_SCALE, scr, F.lane);
        else transpose_item(cc < 128 ? A.in[21] : A.in[22], DFF, WSP(bf16, WS_WGUT), DM, 64 * kb, 32 * nb, pn * 128 + (cc & 127), scr, F.lane);
        return; } r -= I_GU;
    { const int nblk = DM / 32, kb = r / nblk, nb = r % nblk;
        transpose_item_fp8(A.in[23], DM, WSP(unsigned char, WS_WDT), DFF, 64 * kb, 32 * nb, 32 * nb + c, WD_SCALE, scr, F.lane); }
}
constexpr int NBG_T = (NITEMS - I_EARLY) / 64, NBG_A = 16 * 32, NBG = NBG_T + NBG_A;
constexpr int NBG_D0 = (I_O + I_GU) / 64, NBG_D = I_D / 64, NBG_MAIN = NBG - NBG_D;
static_assert((I_O + I_GU) % 64 == 0 && I_D % 64 == 0, "background queues: whole units");
static_assert((NITEMS - I_EARLY) % 64 == 0, "background transposes: whole units");
__device__ __forceinline__ void background_unit(Frame& F, const Args& A, int g) {
    if (g < NBG_T) {
        LAS float* scr = (LAS float*)(F.lds + RING_OFF + F.wave * 16384);
#pragma unroll 1
        for (int j = 0; j < 8; ++j) transpose_one(F, A, I_EARLY + 64 * g + 8 * j + F.wave, scr);
    } else { const int u = g - NBG_T; adaln_unit(F, A, 8 + (u & 15), u >> 4); }
}
__device__ __forceinline__ void background_drain(Frame& F, const Args& A, int qword, int nunits = NBG_MAIN, int skip_at = NBG_D0, int skip_len = NBG_D) {
    volatile LAS int* slot = (volatile LAS int*)(F.lds + MISC_OFF + 64);
    unsigned* head = F.ctl + qword;
    for (;;) {
        __syncthreads();
        if (F.tid == 0) *slot = (int)__hip_atomic_fetch_add(head, 1u, __ATOMIC_RELAXED, __HIP_MEMORY_SCOPE_AGENT);
        __syncthreads();
        const int idx = *slot;
        if (idx >= nunits) break;
        background_unit(F, A, idx < skip_at ? idx : idx + skip_len);
    }
}

__device__ __forceinline__ void background_take(Frame& F, const Args& A, int qword, int n) {
    volatile LAS int* slot = (volatile LAS int*)(F.lds + MISC_OFF + 64);
    unsigned* head = F.ctl + qword;
#pragma unroll 1
    for (int k = 0; k < n; ++k) {
        __syncthreads();
        if (F.tid == 0) *slot = (int)__hip_atomic_fetch_add(head, 1u, __ATOMIC_RELAXED, __HIP_MEMORY_SCOPE_AGENT);
        __syncthreads();
        const int idx = *slot;
        if (idx >= NBG_MAIN) break;
        background_unit(F, A, idx < NBG_D0 ? idx : idx + NBG_D);
    }
    __syncthreads();
}

__device__ __forceinline__ void ph_prologue(Frame& F, const Args& A, int parts) {
    if (parts & 1) { for (int u = blockIdx.x; u < 8 * 32; u += F.G) adaln_unit(F, A, u & 7, u >> 3); }
    if (parts & 16) adaln_reduce(F, A, 0, 2 * DM);
    if (parts & 2) {
        float* cosT = WSP(float, WS_COS); float* sinT = WSP(float, WS_SIN);
        for (int idx = blockIdx.x * 512 + F.tid; idx < SEQ * 32; idx += F.G * 512) { const int pos = idx >> 5, i = idx & 31;
            const double inv = exp(-(double)i * (1.0 / 32.0) * 9.210340371976184); const double a = (double)pos * inv;
            cosT[idx] = (float)cos(a); sinT[idx] = (float)sin(a); }
    }
    if (parts & 4) {
        const float* cl = A.in[2]; const float* ck = A.in[3]; bf16* LATA = WSP(bf16, WS_LATA) + (size_t)MT * KVLORA; bf16* KR = WSP(bf16, WS_KR) + (size_t)MT * ROPE;
        for (size_t i = (size_t)blockIdx.x * 512 + F.tid; i < (size_t)MC * KVLORA / 4; i += (size_t)F.G * 512) *(v2u*)(LATA + 4 * i) = pk4(*(const f32x4*)(cl + 4 * i));
        for (size_t i = (size_t)blockIdx.x * 512 + F.tid; i < (size_t)MC * ROPE / 4; i += (size_t)F.G * 512) *(v2u*)(KR + 4 * i) = pk4(*(const f32x4*)(ck + 4 * i));
    }
    if (parts & 8) {
        LAS float* scr = (LAS float*)(F.lds + RING_OFF + F.wave * 16384);
        for (int it = F.gw; it < I_EARLY; it += F.NGW) transpose_one(F, A, it, scr);
    }
}

__device__ __forceinline__ float wg_sum8(Frame& F, float v) {
    volatile LAS float* part = (volatile LAS float*)(F.lds + MISC_OFF + 256);
    __syncthreads();
    if (F.lane == 0) part[F.wave] = v;
    __syncthreads();
    float t = 0.f;
#pragma unroll
    for (int w = 0; w < 8; ++w) t += part[w];
    return t;
}
template <bool XP16>
__device__ __forceinline__ void ph_modnorm(Frame& F, const void* xp, const float* xs, const float* g, int ch_shift, int ch_scale, bf16* outb, const bf16* slab, int ch_gate, bf16* x1s) {
    const float* MOD = WSP(float, WS_MOD);
    if (XP16) for (int row = F.gw; row < MP; row += F.NGW) {
        const int b = bidx_of(row);
        f32x4 v[16]; float ss = 0.f;
#pragma unroll
        for (int j = 0; j < 8; ++j) { const int col = 8 * F.lane + 512 * j;
            if (XP16) up8h(*(const v4u*)((const bf16*)xp + (size_t)row * XPITCH + col), v[2 * j], v[2 * j + 1]);
            else { v[2 * j] = *(const f32x4*)((const float*)xp + (size_t)row * DM + col); v[2 * j + 1] = *(const f32x4*)((const float*)xp + (size_t)row * DM + col + 4); } }
#pragma unroll
        for (int j = 0; j < 16; ++j) ss += (v[j][0] * v[j][0] + v[j][1] * v[j][1]) + (v[j][2] * v[j][2] + v[j][3] * v[j][3]);
        const float rstd = 1.0f / sqrtf(wave_sum(ss) * (1.0f / DM) + EPS);
        const float* shp = MOD + (size_t)b * NMOD + ch_shift * DM; const float* scp = MOD + (size_t)b * NMOD + ch_scale * DM;
#pragma unroll
        for (int j = 0; j < 8; ++j) { const int col = 8 * F.lane + 512 * j; f32x4 o[2];
#pragma unroll
            for (int q = 0; q < 2; ++q) { const f32x4 gg = *(const f32x4*)(g + col + 4 * q), sc = *(const f32x4*)(scp + col + 4 * q), sh = *(const f32x4*)(shp + col + 4 * q);
                o[q] = v[2 * j + q] * rstd * gg * (1.0f + sc) + sh; }
            if (col >= GU_KB16) { v2u w; w.x = pk4f8(o[0], H8_SCALE); w.y = pk4f8(o[1], H8_SCALE); *(v2u*)((unsigned char*)outb + (size_t)row * (2 * DM) + GU_KB16 + col) = w; }
            else *(v4u*)(outb + (size_t)row * DM + col) = pk8(o[0], o[1]); }
    }
    if (!XP16) for (int row = F.gw; row < MP; row += F.NGW) {
        const int b = bidx_of(row);
        f32x4 v[16]; float ss = 0.f;
#pragma unroll
        for (int j = 0; j < 16; ++j) v[j] = XP16 ? up4h(*(const v2u*)((const bf16*)xp + (size_t)row * DM + 4 * F.lane + 256 * j)) : *(const f32x4*)((const float*)xp + (size_t)row * DM + 4 * F.lane + 256 * j);
#pragma unroll
        for (int j = 0; j < 16; ++j) ss += (v[j][0] * v[j][0] + v[j][1] * v[j][1]) + (v[j][2] * v[j][2] + v[j][3] * v[j][3]);
        const float rstd = 1.0f / sqrtf(wave_sum(ss) * (1.0f / DM) + EPS);
        const float* shp = MOD + (size_t)b * NMOD + ch_shift * DM; const float* scp = MOD + (size_t)b * NMOD + ch_scale * DM;
#pragma unroll
        for (int j = 0; j < 16; ++j) { const int col = 4 * F.lane + 256 * j;
            const f32x4 gg = *(const f32x4*)(g + col), sc = *(const f32x4*)(scp + col), sh = *(const f32x4*)(shp + col);
            const f32x4 o = v[j] * rstd * gg * (1.0f + sc) + sh;
            *(v2u*)(outb + (size_t)row * DM + col) = pk4(o); }
    }
    for (int sr = blockIdx.x; sr < MS; sr += F.G) {
        const int row = MP + sr, b = bidx_of(row);
        f32x4 v[2]; float ss = 0.f;
#pragma unroll
        for (int j = 0; j < 2; ++j) { const int col = 512 * F.wave + 4 * F.lane + 256 * j; v[j] = *(const f32x4*)(xs + (size_t)sr * DM + col);
            if (slab != nullptr) { f32x4 a = (f32x4){0.f, 0.f, 0.f, 0.f};
#pragma unroll
                for (int sI = 0; sI < 16; ++sI) a += up4h(*(const v2u*)(slab + ((size_t)sI * MS + sr) * DM + col));
                v[j] += *(const f32x4*)(MOD + (size_t)b * NMOD + ch_gate * DM + col) * a;
                *(v2u*)(x1s + (size_t)sr * DM + col) = pk4h(v[j]); }
            ss += (v[j][0] * v[j][0] + v[j][1] * v[j][1]) + (v[j][2] * v[j][2] + v[j][3] * v[j][3]); }
        const float rstd = 1.0f / sqrtf(wg_sum8(F, wave_sum(ss)) * (1.0f / DM) + EPS);
        const float* shp = MOD + (size_t)b * NMOD + ch_shift * DM; const float* scp = MOD + (size_t)b * NMOD + ch_scale * DM;
#pragma unroll
        for (int j = 0; j < 2; ++j) { const int col = 512 * F.wave + 4 * F.lane + 256 * j;
            const f32x4 gg = *(const f32x4*)(g + col), sc = *(const f32x4*)(scp + col), sh = *(const f32x4*)(shp + col);
            const f32x4 o = v[j] * rstd * gg * (1.0f + sc) + sh;
            if (XP16 && col >= GU_KB16) *(unsigned*)((unsigned char*)outb + (size_t)row * (2 * DM) + GU_KB16 + col) = pk4f8(o, H8_SCALE);
            else *(v2u*)(outb + (size_t)row * DM + col) = pk4(o); }
    }
}

__device__ __forceinline__ void ph_latent_finalize(Frame& F, const Args& A) {
    const float* KVSS = WSP(float, WS_KVSS); const float* g = A.in[14];
    for (int row = F.gw; row < MT; row += F.NGW) {
        float* p = row < MP ? F.out + OUT_PLAT + (size_t)row * KVLORA : F.out + OUT_SLAT + (size_t)(row - MP) * KVLORA;
        const f32x4 a = *(const f32x4*)(KVSS + row * 8), b = *(const f32x4*)(KVSS + row * 8 + 4);
        const float rstd = 1.0f / sqrtf(((a[0] + a[1]) + (a[2] + a[3]) + (b[0] + b[1]) + (b[2] + b[3])) * (1.0f / KVLORA) + EPS);
#pragma unroll
        for (int j = 0; j < 2; ++j) { const int col = 4 * F.lane + 256 * j; f32x4 v = *(const f32x4*)(p + col); const f32x4 gg = *(const f32x4*)(g + col);
            *(f32x4*)(p + col) = v * rstd * gg; }
    }
}

__device__ __forceinline__ void ph_merge_norm(Frame& F, const Args& A) {
    const float* OSS = WSP(float, WS_OSS); bf16* O = WSP(bf16, WS_O); const float* gm = A.in[18]; const float* gs = A.in[19];
    for (int row = F.gw; row < MT; row += F.NGW) {
        float s0 = 0.f, s1 = 0.f;
#pragma unroll
        for (int j = 0; j < 4; ++j) { const f32x4 a = *(const f32x4*)(OSS + row * 32 + 4 * j), b = *(const f32x4*)(OSS + row * 32 + 16 + 4 * j); s0 += (a[0] + a[1]) + (a[2] + a[3]); s1 += (b[0] + b[1]) + (b[2] + b[3]); }
        const float r0 = 1.0f / sqrtf(s0 * (1.0f / 2048.0f) + EPS), r1 = 1.0f / sqrtf(s1 * (1.0f / 2048.0f) + EPS);
#pragma unroll
        for (int j = 0; j < 8; ++j) { const int col = 8 * F.lane + 512 * j; const float r = col < 2048 ? r0 : r1; const float* gp = col < 2048 ? gm + col : gs + (col - 2048);
            const v4u w = *(const v4u*)(O + (size_t)row * DM + col); const f32x4 g0 = *(const f32x4*)gp, g1 = *(const f32x4*)(gp + 4);
            f32x4 a, b; a[0] = __uint_as_float(w.x << 16); a[1] = __uint_as_float(w.x & 0xffff0000u); a[2] = __uint_as_float(w.y << 16); a[3] = __uint_as_float(w.y & 0xffff0000u);
            b[0] = __uint_as_float(w.z << 16); b[1] = __uint_as_float(w.z & 0xffff0000u); b[2] = __uint_as_float(w.w << 16); b[3] = __uint_as_float(w.w & 0xffff0000u);
            const v2u pa = pk4(a * r * g0), pb = pk4(b * r * g1); v4u o; o.x = pa.x; o.y = pa.y; o.z = pb.x; o.w = pb.y;
            *(v4u*)(O + (size_t)row * DM + col) = o; }
    }
}

__device__ __forceinline__ void ph_final_norm(Frame& F, const Args& A) {
    const float* g = A.in[24]; const float* MOD = WSP(float, WS_MOD); const bf16* slab = WSP(bf16, WS_SLAB); const bf16* X1 = WSP(bf16, WS_X1); const bf16* X2 = WSP(bf16, WS_X2);
    for (int row = F.gw; row < MP; row += F.NGW) {
        float* p = F.out + OUT_Y + (size_t)row * DM;
        f32x4 v[16]; float ss = 0.f;
#pragma unroll
        for (int j = 0; j < 16; ++j) v[j] = up4h(*(const v2u*)(X2 + (size_t)row * DM + 4 * F.lane + 256 * j));
#pragma unroll
        for (int j = 0; j < 16; ++j) ss += (v[j][0] * v[j][0] + v[j][1] * v[j][1]) + (v[j][2] * v[j][2] + v[j][3] * v[j][3]);
        const float rstd = 1.0f / sqrtf(wave_sum(ss) * (1.0f / DM) + EPS);
#pragma unroll
        for (int j = 0; j < 16; ++j) { const int col = 4 * F.lane + 256 * j; __builtin_nontemporal_store(v[j] * rstd * *(const f32x4*)(g + col), (f32x4*)(p + col)); }
    }
    for (int sr = blockIdx.x; sr < MS; sr += F.G) {
        const int row = MP + sr; float* p = F.out + OUT_Y + (size_t)row * DM;
        const float* gp = MOD + (size_t)bidx_of(row) * NMOD + 5 * DM;
        f32x4 v[2]; float ss = 0.f;
#pragma unroll
        for (int j = 0; j < 2; ++j) { const int col = 512 * F.wave + 4 * F.lane + 256 * j; f32x4 a = (f32x4){0.f, 0.f, 0.f, 0.f};
#pragma unroll
            for (int sI = 0; sI < 16; ++sI) a += up4h(*(const v2u*)(slab + ((size_t)sI * MS + sr) * DM + col));
            v[j] = up4h(*(const v2u*)(X1 + (size_t)row * DM + col)) + *(const f32x4*)(gp + col) * a;
            ss += (v[j][0] * v[j][0] + v[j][1] * v[j][1]) + (v[j][2] * v[j][2] + v[j][3] * v[j][3]); }
        const float rstd = 1.0f / sqrtf(wg_sum8(F, wave_sum(ss)) * (1.0f / DM) + EPS);
#pragma unroll
        for (int j = 0; j < 2; ++j) { const int col = 512 * F.wave + 4 * F.lane + 256 * j; __builtin_nontemporal_store(v[j] * rstd * *(const f32x4*)(g + col), (f32x4*)(p + col)); }
    }
}

__device__ __forceinline__ int crow(int i, int h) { return (i & 3) + 8 * (i >> 2) + 4 * h; }
__device__ __forceinline__ unsigned voff_b(unsigned row, unsigned ch) { return 256u * row + 16u * (ch ^ (((row & 3u) << 2) | ((row >> 2) & 3u))); }
__device__ __forceinline__ v4u cvt8(const float* p) { const f32x4 a = *(const f32x4*)p, b = *(const f32x4*)(p + 4); const v2u x = pk4(a), y = pk4(b); v4u o; o.x = x.x; o.y = x.y; o.z = y.x; o.w = y.y; return o; }

template <int MODE>
__device__ __forceinline__ void attn_unit(Frame& F, const float* csk, const float* csv, bool sample, int b, int h, int qb) {
    constexpr int DQK = MODE == 0 ? 192 : 128, NS = DQK / 16, KP = DQK * 2 + 16, KCH = DQK / 8, NKC = KCH / 8;
    constexpr int VP = 320;
    constexpr int LDS_K = 0, LDS_V = 64 * KP, BUFB = LDS_V + 64 * VP;
    LAS unsigned char* lds = F.lds + RING_OFF;
    volatile LAS int* flags = (volatile LAS int*)(F.lds + MISC_OFF + 128);
    const int lane = F.lane, wave = F.wave, tid = F.tid, l31 = lane & 31, hh = lane >> 5;
    const int qrow0 = sample ? MP + 32 * b : b * SEQ + 256 * qb;
    const int qpos0 = sample ? PAST : 256 * qb;
    const bool wact = sample ? (wave == 0) : true;
    const int qrow = qrow0 + 32 * wave + l31, qpos = qpos0 + 32 * wave + l31;
    const bf16* KVb = WSP(bf16, WS_KV); const bf16* KRb = WSP(bf16, WS_KR);
    const bf16* SBKb = WSP(bf16, WS_SBK); const bf16* SBVb = WSP(bf16, WS_SBV);
    bf16x8 qf[NS];
    if (wact) {
        const bf16* qp = MODE == 0 ? WSP(bf16, WS_QM) + (size_t)qrow * 3072 + h * 192 + 8 * hh : WSP(bf16, WS_SBQ) + (size_t)qrow * 2048 + h * 128 + 8 * hh;
#pragma unroll
        for (int s = 0; s < NS; ++s) qf[s] = *(const bf16x8*)(qp + 16 * s);
    } else {
#pragma unroll
        for (int s = 0; s < NS; ++s) qf[s] = (bf16x8){0, 0, 0, 0, 0, 0, 0, 0};
    }
    f32x16 o[4];
#pragma unroll
    for (int c = 0; c < 4; ++c)
#pragma unroll
        for (int i = 0; i < 16; ++i) o[c][i] = 0.f;
    float mrun = -INFINITY, lrun = 0.f, prun = 1.0f;
    bool started = false, started0 = false, wdone = false;
    const int nblk = sample ? 33 : 4 * qb + 4;
    const unsigned tq = (lane & 15) >> 2, tp = lane & 3, tblk = (lane >> 4) & 1;
#define BLK_J(it) (MODE == 0 ? (it) : nblk - 1 - (it))
#define BLK_NEW(j) (sample && (j) == 32)
#define BLK_ROW(j) (sample ? (BLK_NEW(j) ? MP + 32 * b : MT + b * PAST + 64 * (j)) : b * SEQ + 64 * (j))
#define BLK_F32(j) (MODE == 1 && sample && !BLK_NEW(j))
    v4u pk[NKC], pv[2];
    const int r0 = tid >> 4, chv = tid & 15, rr = tid >> 3, chr = tid & 7;
    constexpr unsigned SRCP = MODE == 0 ? 8192u : 4096u;
    const unsigned goff = (unsigned)r0 * SRCP + 16u * chv + (unsigned)h * 256u;
    const unsigned lk0 = (unsigned)r0 * KP + 16u * chv, lv0 = (unsigned)r0 * VP + 16u * chv, lkr = (unsigned)rr * KP + 256u + 16u * chr;
#define ISSUE(j) do { if (!BLK_F32(j)) { const int krow_ = BLK_ROW(j); \
        const char* kb_ = (const char*)(MODE == 0 ? KVb : SBKb) + (size_t)krow_ * SRCP; const char* vb_ = MODE == 0 ? kb_ + 4096 : (const char*)SBVb + (size_t)krow_ * SRCP; \
        pk[0] = *(const v4u*)(kb_ + goff); pk[1] = *(const v4u*)(kb_ + goff + 32u * SRCP); \
        if (MODE == 0) pk[NKC - 1] = *(const v4u*)((const char*)KRb + (size_t)krow_ * 128 + rr * 128 + 16 * chr); \
        pv[0] = *(const v4u*)(vb_ + goff); pv[1] = *(const v4u*)(vb_ + goff + 32u * SRCP); } } while (0)
#define WRITE(j, bufo) do { const bool half_ = BLK_NEW(j); \
        if (BLK_F32(j)) { const size_t fo_ = ((size_t)(b * PAST + 64 * (j)) * NH + h) * SBD + (size_t)r0 * (NH * SBD) + 8 * chv; \
            pk[0] = cvt8(csk + fo_); pk[1] = cvt8(csk + fo_ + 32 * NH * SBD); pv[0] = cvt8(csv + fo_); pv[1] = cvt8(csv + fo_ + 32 * NH * SBD); } \
        const v4u z_ = (v4u){0u, 0u, 0u, 0u}; \
        *(LAS v4u*)(lds + (bufo) + LDS_K + lk0) = pk[0]; *(LAS v4u*)(lds + (bufo) + LDS_K + lk0 + 32 * KP) = half_ ? z_ : pk[1]; \
        if (MODE == 0) *(LAS v4u*)(lds + (bufo) + LDS_K + lkr) = (half_ && rr >= 32) ? z_ : pk[NKC - 1]; \
        *(LAS v4u*)(lds + (bufo) + LDS_V + lv0) = pv[0]; *(LAS v4u*)(lds + (bufo) + LDS_V + lv0 + 32 * VP) = half_ ? z_ : pv[1]; } while (0)
#pragma unroll
    for (int i = 0; i < NKC; ++i) pk[i] = (v4u){0u, 0u, 0u, 0u};
    pv[0] = (v4u){0u, 0u, 0u, 0u}; pv[1] = (v4u){0u, 0u, 0u, 0u};
    ISSUE(BLK_J(0));
    int bufo = 0;
    for (int it = 0; it < nblk; ++it) {
        const int j = BLK_J(it);
        const int kpos0 = 64 * j, nvalid = BLK_NEW(j) ? 32 : 64;
        WRITE(j, bufo);
        if (it + 1 < nblk) { const int jn = BLK_J(it + 1); ISSUE(jn); }
        __syncthreads();
        if (MODE == 1 && it > 0) { const int f = flags[((it - 1) & 1) * 8 + (lane & 7)]; if (__all(f != 0)) break; }
        bool need;
        if (MODE == 0) need = wact && (sample || j <= ((256 * qb + 32 * wave) >> 6));
        else need = wact && !wdone && (kpos0 < qpos0 + 32 * wave + 31);
        if (need) {
            started = true;
            LAS unsigned char* kb = lds + bufo + LDS_K; LAS unsigned char* vb = lds + bufo + LDS_V;
            bf16x8 pf[4];
            if (MODE == 0) {
                const LAS unsigned char* vl = vb + (4 * hh + tq) * VP + 32 * tblk + 8 * tp;
                const bool two = nvalid > 32;
                f32x16 s0, s1; const float nref = started0 ? -mrun : 0.f;
#pragma unroll
                for (int i = 0; i < 16; ++i) { s0[i] = nref; s1[i] = nref; }
                {
                    constexpr int PF = 3, NF = 2 * NS;
                    const int nf = two ? NF : NS;
                    bf16x8 kq[PF];
#define KFRAG(f) (*(const LAS bf16x8*)(kb + (((f) >= NS ? 32 : 0) + l31) * KP + 32 * ((f) >= NS ? (f) - NS : (f)) + 16 * hh))
#pragma unroll
                    for (int f = 0; f < PF; ++f) kq[f] = KFRAG(f);
                    __builtin_amdgcn_sched_barrier(0);
#pragma unroll
                    for (int f = 0; f < NF; ++f) {
                        if (f < NS || two) {
                            const bf16x8 kc = kq[f % PF];
                            if (f + PF < NF && (f + PF < NS || two)) kq[f % PF] = KFRAG(f + PF);
                            if (f < NS) s0 = __builtin_amdgcn_mfma_f32_32x32x16_bf16(kc, qf[f], s0, 0, 0, 0);
                            else s1 = __builtin_amdgcn_mfma_f32_32x32x16_bf16(kc, qf[f - NS], s1, 0, 0, 0);
                            __builtin_amdgcn_sched_barrier(0);
                        }
                    }
#undef KFRAG
                    (void)nf;
                }
                __builtin_amdgcn_sched_barrier(0);
#define MLA_HALF(SV, KS0, FIX_OTHER) do { \
                    float mx_ = SV[0]; \
                    _Pragma("unroll") for (int i = 1; i < 16; ++i) mx_ = fmaxf(mx_, SV[i]); \
                    mx_ = fmaxf(mx_, __shfl_xor(mx_, 32)); \
                    if (__any(!started0 || mx_ > 8.0f)) {     \
                        const float dl_ = started0 ? fmaxf(mx_, 0.f) : mx_; const float alpha_ = started0 ? __builtin_amdgcn_exp2f(-dl_) : 0.f; \
                        mrun = started0 ? mrun + dl_ : dl_; lrun *= alpha_; \
                        _Pragma("unroll") for (int i = 0; i < 16; ++i) SV[i] -= dl_; \
                        if (FIX_OTHER) { _Pragma("unroll") for (int i = 0; i < 16; ++i) s1[i] -= dl_; } \
                        _Pragma("unroll") for (int c = 0; c < 4; ++c) _Pragma("unroll") for (int i = 0; i < 16; ++i) o[c][i] *= alpha_; \
                    } \
                    started0 = true; \
                    float ps_ = 0.f; \
                    _Pragma("unroll") for (int i = 0; i < 16; ++i) { SV[i] = __builtin_amdgcn_exp2f(SV[i]); ps_ += SV[i]; } \
                    lrun += ps_; \
                    _Pragma("unroll") for (int s2 = 0; s2 < 2; ++s2) { const int r0_ = 8 * s2; v4u w; \
                        w.x = pk2(SV[r0_], SV[r0_ + 1]); w.y = pk2(SV[r0_ + 2], SV[r0_ + 3]); w.z = pk2(SV[r0_ + 4], SV[r0_ + 5]); w.w = pk2(SV[r0_ + 6], SV[r0_ + 7]); \
                        pf[(KS0) + s2] = __builtin_bit_cast(bf16x8, w); } \
                    {     \
                        s16x4 vlo_[3], vhi_[3]; \
                        _Pragma("unroll") for (int f = 0; f < 2; ++f) { const int ks = (KS0) + (f >> 2), c = f & 3; \
                            vlo_[f] = __builtin_bit_cast(s16x4, __builtin_amdgcn_ds_read_tr16_b64_v4i16((LAS s16x4*)(vl + (16 * ks) * VP + 64 * c))); \
                            vhi_[f] = __builtin_bit_cast(s16x4, __builtin_amdgcn_ds_read_tr16_b64_v4i16((LAS s16x4*)(vl + (16 * ks + 8) * VP + 64 * c))); } \
                        _Pragma("unroll") for (int f = 0; f < 8; ++f) { const int ks = (KS0) + (f >> 2), c = f & 3; \
                            if (f + 2 < 8) { const int ks2 = (KS0) + ((f + 2) >> 2), c2 = (f + 2) & 3; \
                                vlo_[(f + 2) % 3] = __builtin_bit_cast(s16x4, __builtin_amdgcn_ds_read_tr16_b64_v4i16((LAS s16x4*)(vl + (16 * ks2) * VP + 64 * c2))); \
                                vhi_[(f + 2) % 3] = __builtin_bit_cast(s16x4, __builtin_amdgcn_ds_read_tr16_b64_v4i16((LAS s16x4*)(vl + (16 * ks2 + 8) * VP + 64 * c2))); } \
                            const bf16x8 vf = __builtin_shufflevector(vlo_[f % 3], vhi_[f % 3], 0, 1, 2, 3, 4, 5, 6, 7); \
                            o[c] = __builtin_amdgcn_mfma_f32_32x32x16_bf16(vf, pf[ks], o[c], 0, 0, 0); } \
                        __builtin_amdgcn_sched_barrier(0); } } while (0)
                MLA_HALF(s0, 0, two);
                if (two) MLA_HALF(s1, 2, false);
#undef MLA_HALF
            } else {
#pragma unroll
                for (int tI = 1; tI >= 0; --tI) {
                    f32x16 sv;
#pragma unroll
                    for (int i = 0; i < 16; ++i) sv[i] = 0.f;
                    {
                        constexpr int PFK = 3; bf16x8 kq[PFK];
#define KFRAG1(f) (*(const LAS bf16x8*)(kb + (32 * tI + l31) * KP + 32 * (f) + 16 * hh))
#pragma unroll
                        for (int f = 0; f < PFK; ++f) kq[f] = KFRAG1(f);
                        __builtin_amdgcn_sched_barrier(0);
#pragma unroll
                        for (int f = 0; f < NS; ++f) { const bf16x8 kc = kq[f % PFK];
                            if (f + PFK < NS) kq[f % PFK] = KFRAG1(f + PFK);
                            sv = __builtin_amdgcn_mfma_f32_32x32x16_bf16(kc, qf[f], sv, 0, 0, 0);
                            __builtin_amdgcn_sched_barrier(0); }
#undef KFRAG1
                    }
                    float kp[16];
                    const int lim = min(qpos - kpos0, nvalid) - 32 * tI;
#pragma unroll
                    for (int i = 0; i < 16; ++i) { const bool ok = crow(i, hh) < lim;
                        const float z = __builtin_amdgcn_fmed3f(sv[i], -126.0f, 126.0f); const float e = __builtin_amdgcn_exp2f(-z); const float r = __builtin_amdgcn_rcpf(1.0f + e);
                        kp[i] = ok ? e * r : 1.0f; sv[i] = ok ? r : 0.f; }
                    float G[4], Go[4];
#pragma unroll
                    for (int g = 0; g < 4; ++g) { G[g] = (kp[4 * g] * kp[4 * g + 1]) * (kp[4 * g + 2] * kp[4 * g + 3]); Go[g] = __shfl_xor(G[g], 32); }
                    float later = prun;
#pragma unroll
                    for (int g = 3; g >= 0; --g) {
                        float tl = hh == 0 ? later * Go[g] : later;
#pragma unroll
                        for (int e = 3; e >= 0; --e) { const int i = 4 * g + e; sv[i] *= tl; tl *= kp[i]; }
                        later *= G[g] * Go[g];
                    }
                    prun = later;
#pragma unroll
                    for (int s2 = 0; s2 < 2; ++s2) { const int r0_ = 8 * s2; v4u w;
                        w.x = pk2(sv[r0_], sv[r0_ + 1]); w.y = pk2(sv[r0_ + 2], sv[r0_ + 3]); w.z = pk2(sv[r0_ + 4], sv[r0_ + 5]); w.w = pk2(sv[r0_ + 6], sv[r0_ + 7]);
                        pf[2 * tI + s2] = __builtin_bit_cast(bf16x8, w); }
                    __builtin_amdgcn_sched_barrier(0);
                }
            }
            if (MODE == 1) {
                const LAS unsigned char* vl = vb + (4 * hh + tq) * VP + 32 * tblk + 8 * tp;
                s16x4 vlo_[3], vhi_[3];
#define VFRAG1(f, slot) do { const int ks_ = (f) >> 2, c_ = (f) & 3; \
                    vlo_[slot] = __builtin_bit_cast(s16x4, __builtin_amdgcn_ds_read_tr16_b64_v4i16((LAS s16x4*)(vl + (16 * ks_) * VP + 64 * c_))); \
                    vhi_[slot] = __builtin_bit_cast(s16x4, __builtin_amdgcn_ds_read_tr16_b64_v4i16((LAS s16x4*)(vl + (16 * ks_ + 8) * VP + 64 * c_))); } while (0)
                VFRAG1(0, 0); VFRAG1(1, 1);
                __builtin_amdgcn_sched_barrier(0);
#pragma unroll
                for (int f = 0; f < 16; ++f) {
                    if (f + 2 < 16) VFRAG1(f + 2, (f + 2) % 3);
                    const bf16x8 vf = __builtin_shufflevector(vlo_[f % 3], vhi_[f % 3], 0, 1, 2, 3, 4, 5, 6, 7);
                    o[f & 3] = __builtin_amdgcn_mfma_f32_32x32x16_bf16(vf, pf[f >> 2], o[f & 3], 0, 0, 0);
                    __builtin_amdgcn_sched_barrier(0);
                }
#undef VFRAG1
            }
        }
        if (MODE == 1) {
            wdone = started && __all(prun < 1.1102230246251565e-16f);
            if (lane == 0) flags[(it & 1) * 8 + wave] = (!wact || wdone) ? 1 : 0;
        }
        bufo ^= BUFB;
    }
#undef BLK_J
#undef BLK_NEW
#undef BLK_ROW
#undef BLK_F32
#undef ISSUE
#undef WRITE
    if (wact) {
        float inv = 1.0f;
        if (MODE == 0) { const float lt = lrun + __shfl_xor(lrun, 32); inv = 1.0f / lt; }
        bf16* Ob = WSP(bf16, WS_O) + (size_t)qrow * DM + (MODE == 0 ? 0 : 2048) + h * 128;
        float ss = 0.f;
#pragma unroll
        for (int c = 0; c < 4; ++c)
#pragma unroll
            for (int g = 0; g < 4; ++g) { f32x4 v; v[0] = o[c][4 * g] * inv; v[1] = o[c][4 * g + 1] * inv; v[2] = o[c][4 * g + 2] * inv; v[3] = o[c][4 * g + 3] * inv;
                ss += (v[0] * v[0] + v[1] * v[1]) + (v[2] * v[2] + v[3] * v[3]);
                *(v2u*)(Ob + 32 * c + 8 * g + 4 * hh) = pk4(v); }
        ss += __shfl_xor(ss, 32);
        if (hh == 0) WSP(float, WS_OSS)[qrow * 32 + (MODE == 0 ? 0 : 16) + h] = ss;
    }
}

__device__ __forceinline__ void ph_attention(Frame& F, const Args& A, int qword, int mask) {
    const float* csk = A.in[4]; const float* csv = A.in[5];
    volatile LAS int* slot = (volatile LAS int*)(F.lds + MISC_OFF + 64);
    unsigned* head = F.ctl + qword;
    for (;;) {
        __syncthreads();
        if (F.tid == 0) *slot = (int)__hip_atomic_fetch_add(head, 1u, __ATOMIC_RELAXED, __HIP_MEMORY_SCOPE_AGENT);
        __syncthreads();
        const int id = *slot;
        if (id >= 1280) break;
        if (id < 128) { if (mask & 1) attn_unit<0>(F, csk, csv, true, id >> 4, id & 15, 0); }
        else if (id < 256) { const int bh = id - 128; if (mask & 2) attn_unit<1>(F, csk, csv, true, bh >> 4, bh & 15, 0); }
        else { const int pid = id - 256; const int qb = 15 - (pid >> 6), jj = pid & 63, bh = jj >> 1; if (jj & 1) { if (mask & 8) attn_unit<1>(F, csk, csv, false, bh >> 4, bh & 15, qb); } else { if (mask & 4) attn_unit<0>(F, csk, csv, false, bh >> 4, bh & 15, qb); } }
    }
}

constexpr int NPHASE = 11;
__global__ void __launch_bounds__(NWAVES * 64, 2) mk_fwd(Args args) {
    extern __shared__ __attribute__((aligned(16))) unsigned char lds[];
    Frame F;
    F.lds = (LAS unsigned char*)lds;
    F.MISC = (volatile LAS unsigned*)(F.lds + MISC_OFF);
    F.tid = threadIdx.x; F.lane = F.tid & 63; F.wave = __builtin_amdgcn_readfirstlane(F.tid >> 6);
    F.G = gridDim.x; F.gw = blockIdx.x * NWAVES + F.wave; F.NGW = F.G * NWAVES;
    F.ws = args.ws; F.ctl = (unsigned*)(args.ws + WS_CTL); F.out = args.out;
    for (int u = F.tid; u < (LDS_BYTES - LDSCTL_OFF) / 4; u += NWAVES * 64) ((LAS unsigned*)(F.lds + LDSCTL_OFF))[u] = 0u;
    __syncthreads();
    XcdBarrier bar; bar.bar = F.ctl + CW_BAR; bar.x = 0; bar.st = nullptr;
    const int lo = args.ph_lo, hi = args.ph_hi;
    bar = xcd_barrier_post(F.ctl + CW_BAR, F.MISC + 8);
#define IN(k) (lo <= (k) && (k) < hi)
#define SEAM(k) do { if (IN(k) && IN((k) + 1)) xcd_barrier(bar); } while (0)

#define DUP(k, ...) do { __VA_ARGS__ if (PROBE_DUP == (k)) { xcd_barrier(bar); __VA_ARGS__ } } while (0)
    if (IN(0)) { ph_prologue(F, args, 1); xcd_barrier(bar); ph_prologue(F, args, 2 | 4 | 8 | 16); if (PROBE_DUP >= 100 && PROBE_DUP < 132) { xcd_barrier(bar); ph_prologue(F, args, PROBE_DUP - 100); } } SEAM(0);
    if (IN(1)) { DUP(1, ph_modnorm<false>(F, args.in[0], args.in[1], args.in[10], 0, 1, WSP(bf16, WS_H), nullptr, 0, nullptr);); } SEAM(1);
    if (IN(2)) {
        DUP(20,
        {
            pg8::Gemm g{WSP(bf16, WS_H), WSP(bf16, WS_W1T), MT, N1, DM}; pg8::StaticOrder S; S.init(MT, N1, F.G, (int)blockIdx.x, DM);
            Epi1 E{args.in[13], args.in[14], F.ws, F.out};
            pg8::gemm_phase<Epi1, pg8::StaticOrder, PG8_ALIGN, PG8_SP2>(F.lds + RING_OFF, g, S, E);
        });
    } SEAM(2);
    if (IN(3)) {
        DUP(3,
        {
            pg8::Gemm g{WSP(bf16, WS_LATA), WSP(bf16, WS_WUKVT), MP, 4096, KVLORA}; pg8::StaticOrder S; S.init(MP, 4096, F.G, (int)blockIdx.x, KVLORA);
            Epi2b E{WSP(float, WS_KVSS), WSP(bf16, WS_KV), 0};
            pg8::gemm_phase<Epi2b, pg8::StaticOrder, PG8_ALIGN, PG8_SP2>(F.lds + RING_OFF, g, S, E);
        }
        {
            pg8::Gemm g{WSP(bf16, WS_A2A), WSP(bf16, WS_WUQT), MT, 3072, QLORA}; pg8::StaticOrder S; S.init(MT, 3072, F.G, (int)blockIdx.x, QLORA);
            Epi2a E{WSP(float, WS_QSS), WSP(float, WS_COS), WSP(float, WS_SIN), WSP(bf16, WS_QM)};
            pg8::gemm_phase<Epi2a, pg8::StaticOrder, PG8_ALIGN, PG8_SP2>(F.lds + RING_OFF, g, S, E);
        }
        {
            const int first_idle = ((MT / 256) * (3072 / 256)) % F.G; const int cs = (int)blockIdx.x >= first_idle ? (int)blockIdx.x - first_idle : (1 << 24);
            pg8::Gemm g{WSP(bf16, WS_LATA) + (size_t)MP * KVLORA, WSP(bf16, WS_WUKVT), MS, 4096, KVLORA}; pg8::StaticOrder S; S.init(MS, 4096, F.G, cs, KVLORA);
            Epi2b E{WSP(float, WS_KVSS), WSP(bf16, WS_KV), MP};
            pg8::gemm_phase<Epi2b, pg8::StaticOrder, PG8_ALIGN, PG8_SP2>(F.lds + RING_OFF, g, S, E);
        });
        DUP(21,
        {
            pg8::Gemm g{WSP(bf16, WS_LATA) + (size_t)MT * KVLORA, WSP(bf16, WS_WUKVT), MC, 4096, KVLORA}; pg8::StaticOrder S; S.init(MC, 4096, F.G, (int)blockIdx.x, KVLORA);
            Epi2b E{WSP(float, WS_KVSS), WSP(bf16, WS_KV), MT};
            pg8::gemm_phase<Epi2b, pg8::StaticOrder, PG8_ALIGN, PG8_SP2>(F.lds + RING_OFF, g, S, E);
        });
        {
            const int first_idle = ((MT / 256) * (3072 / 256)) % F.G;
            if ((int)blockIdx.x >= first_idle + (MS / 256) * 16) background_take(F, args, CW_QUEUE + 128, 1);
        }
        ph_latent_finalize(F, args);
    } SEAM(3);
    if (IN(4)) {
        if (blockIdx.x & 1) background_drain(F, args, CW_QUEUE + 128);
        ph_attention(F, args, CW_QUEUE, 15);
        background_drain(F, args, CW_QUEUE + 128);
        if (PROBE_DUP >= 40 && PROBE_DUP < 56) { xcd_barrier(bar); ph_attention(F, args, CW_QUEUE + 64, PROBE_DUP - 40); }
        if (PROBE_DUP == 57) { xcd_barrier(bar); if (blockIdx.x & 1) background_drain(F, args, CW_QUEUE + 256); ph_attention(F, args, CW_QUEUE + 64, 15); background_drain(F, args, CW_QUEUE + 256); }
        if (PROBE_DUP == 58) { xcd_barrier(bar); background_drain(F, args, CW_QUEUE + 256); }
    } SEAM(4);
    if (IN(5)) { adaln_reduce(F, args, 2 * DM, NMOD); ph_merge_norm(F, args); } SEAM(5);
    if (IN(6)) {
        DUP(6,
        { pg8::Gemm g{WSP(bf16, WS_O), WSP(bf16, WS_WOUTT), MT, DM, DM}; pg8::TailSplitOrder S; S.init(MP, DM, F.G, (int)blockIdx.x, DM, MP / 256);
        EpiRes<false, false> E{args.in[0], WSP(float, WS_MOD) + 2 * DM, WSP(bf16, WS_X1), WSP(bf16, WS_SLAB), 1.0f};
        pg8::gemm_phase<EpiRes<false, false>, pg8::TailSplitOrder, PG8_ALIGN, PG8_SP2>(F.lds + RING_OFF, g, S, E); });
    } SEAM(6);
    if (IN(7)) { DUP(7, ph_modnorm<true>(F, WSP(bf16, WS_X1), args.in[1], args.in[11], 3, 4, WSP(bf16, WS_H), WSP(bf16, WS_SLAB), 2, WSP(bf16, WS_X1) + (size_t)MP * DM);); } SEAM(7);
    if (IN(8)) {
        DUP(8,
        { pg8::Gemm g{WSP(bf16, WS_H), WSP(bf16, WS_WGUT), MT, NGU, DM}; pg8::StaticOrder S; S.init(MT, NGU, F.G, (int)blockIdx.x, GU_NT * 64);
        EpiGU E{WSP(unsigned char, WS_ACT), WSP(float, WS_SLAB)};
        pg8::gemm_phase<EpiGU, pg8::StaticOrder, PG8_ALIGN, PG8_SP2>(F.lds + RING_OFF, g, S, E); });
        background_drain(F, args, CW_QUEUE + 384, NBG_D, 0, NBG_D0);
    } SEAM(8);
    if (IN(9)) {
        DUP(9,
        { pg8::Gemm g{WSP(bf16, WS_ACT), WSP(bf16, WS_WDT), MT, DM, DFF / 2}; pg8::TailSplitOrder S; S.init(MP, DM, F.G, (int)blockIdx.x, DFF / 2, MP / 256);
        EpiRes<true, true> E{WSP(bf16, WS_X1), WSP(float, WS_MOD) + 5 * DM, WSP(bf16, WS_X2), WSP(bf16, WS_SLAB), 1.0f / (ACT_SCALE * WD_SCALE)};
        pg8::gemm_phase<EpiRes<true, true>, pg8::TailSplitOrder, PG8_ALIGN, PG8_SP2>(F.lds + RING_OFF, g, S, E); });
    } SEAM(9);
    if (IN(10)) { ph_final_norm(F, args); }
#undef DUP
#undef IN
#undef SEAM
}

extern "C" void kernel_launch(void* const* d_in, const int* in_sizes, int n_in, void* d_out, int out_size, void* d_ws, size_t ws_size, hipStream_t stream) {
    static int grid = 0;
    if (grid == 0) {
        if (n_in != 25 || out_size != (int)OUT_TOTAL || ws_size < WS_END) { fprintf(stderr, "kernel_launch: unexpected sizes n_in %d out %d ws %zu\n", n_in, out_size, ws_size); grid = -1; return; }
        int dev = 0, cus = 0, per_cu = 0;
        if (hipGetDevice(&dev) != hipSuccess || hipDeviceGetAttribute(&cus, hipDeviceAttributeMultiprocessorCount, dev) != hipSuccess) { grid = -1; return; }
        if (hipFuncSetAttribute((const void*)mk_fwd, hipFuncAttributeMaxDynamicSharedMemorySize, LDS_BYTES) != hipSuccess) { fprintf(stderr, "kernel_launch: hipFuncSetAttribute failed\n"); grid = -1; return; }
        if (hipOccupancyMaxActiveBlocksPerMultiprocessor(&per_cu, (const void*)mk_fwd, NWAVES * 64, LDS_BYTES) != hipSuccess || per_cu < 1) { fprintf(stderr, "kernel_launch: occupancy query says %d\n", per_cu); }
        (void)hipGetLastError();
        grid = cus;
    }
    if (grid < 0) return;
    if (hipMemsetAsync((char*)d_ws + WS_CTL, 0, CTL_ZERO_BYTES, stream) != hipSuccess) return;
    Args a{};
    for (int i = 0; i < 25; ++i) a.in[i] = (const float*)d_in[i];
    a.out = (float*)d_out; a.ws = (unsigned char*)d_ws;
#if MK_ONE_LAUNCH
    a.ph_lo = 0; a.ph_hi = NPHASE;
    hipLaunchKernelGGL(mk_fwd, dim3(grid), dim3(NWAVES * 64), LDS_BYTES, stream, a);
#else
    for (int p = 0; p < NPHASE; ++p) { a.ph_lo = p; a.ph_hi = p + 1; hipLaunchKernelGGL(mk_fwd, dim3(grid), dim3(NWAVES * 64), LDS_BYTES, stream, a); }
#endif
}
```

```cpp
#include <hip/hip_runtime.h>
#include <cstdio>
#include <cstdint>

#ifndef PROBE_DUP
#define PROBE_DUP -1
#endif
#ifndef MK_ONE_LAUNCH
#define MK_ONE_LAUNCH 1
#endif

constexpr int DM = 4096, SEQ = 4096, NB_P = 2, NB_S = 8, DSEQ = 32, PAST = 2048;
constexpr int MP = NB_P * SEQ;
constexpr int MS = NB_S * DSEQ;
constexpr int MT = MP + MS;
constexpr int MC = NB_S * PAST;
constexpr int ML = MT + MC;
constexpr int NH = 16, QLORA = 1024, KVLORA = 512, ROPE = 64, NOPE = 128, VD = 128, SBD = 128;
constexpr int INCOLS = 7744, N1 = 7936;
constexpr int DFF = 11008, NGU = 2 * DFF;
constexpr int NMOD = 6 * DM;
constexpr float EPS = 1e-6f;
constexpr int XPITCH = DM;
constexpr float LOG2E = 1.4426950408889634f;
constexpr float MLA_QS = 0.07216878364870322f * LOG2E;
constexpr float SB_QS = 0.08838834764831845f * LOG2E;
constexpr int GU_NF8 = 4;
constexpr int GU_KB16 = DM - 128 * GU_NF8, GU_NT16 = GU_KB16 / 64, GU_NT = GU_NT16 + GU_NF8;
constexpr float H8_SCALE = 8.0f, WGU_SCALE = 2048.0f;
constexpr float ACT_SCALE = 8.0f, WD_SCALE = 2048.0f;

constexpr size_t OUT_Y = 0, OUT_PLAT = 34603008, OUT_PKR = 38797312, OUT_PSBK = 39321600, OUT_PSBV = 56098816,
                 OUT_SLAT = 72876032, OUT_SKR = 73007104, OUT_SSBK = 73023488, OUT_SSBV = 73547776, OUT_TOTAL = 74072064;

constexpr size_t MiB = 1u << 20;
constexpr size_t WS_CTL = 0, CTL_ZERO_BYTES = 32 * 1024;
constexpr size_t WS_MOD = 1 * MiB;
constexpr size_t WS_COS = 2 * MiB, WS_SIN = 3 * MiB;
constexpr size_t WS_QSS = 4 * MiB;
constexpr size_t WS_KVSS = 5 * MiB;
constexpr size_t WS_OSS = 6 * MiB;
constexpr size_t WS_W1T = 8 * MiB;
constexpr size_t WS_WUQT = 72 * MiB;
constexpr size_t WS_WUKVT = 80 * MiB;
constexpr size_t WS_WOUTT = 84 * MiB;
constexpr size_t WS_WGUT = 116 * MiB;
constexpr size_t WS_WDT = 288 * MiB;
constexpr size_t WS_H = 376 * MiB;
constexpr size_t WS_A2A = 444 * MiB;
constexpr size_t WS_LATA = 462 * MiB;
constexpr size_t WS_KR = 488 * MiB;
constexpr size_t WS_KV = 492 * MiB;
constexpr size_t WS_QM = 688 * MiB;
constexpr size_t WS_SBQ = 738 * MiB, WS_SBK = 772 * MiB, WS_SBV = 806 * MiB;
constexpr size_t WS_O = 840 * MiB;
constexpr size_t WS_X1 = 908 * MiB;
constexpr size_t WS_X2 = 975 * MiB;
constexpr size_t WS_ACT = 1042 * MiB;
constexpr size_t WS_SLAB = 1222 * MiB;
constexpr size_t WS_ADAP = 1288 * MiB;
constexpr size_t WS_END = 1320 * MiB;
constexpr int CW_BAR = 4096;
constexpr int CW_QUEUE = 64;

#define GAS __attribute__((address_space(1)))
#define LAS __attribute__((address_space(3)))
typedef unsigned short bf16;
typedef unsigned v4u __attribute__((ext_vector_type(4)));
typedef unsigned v2u __attribute__((ext_vector_type(2)));
typedef float f32x4 __attribute__((ext_vector_type(4)));
typedef float f32x2 __attribute__((ext_vector_type(2)));
typedef float f32x16 __attribute__((ext_vector_type(16)));
typedef short bf16x8 __attribute__((ext_vector_type(8)));
typedef short s16x4 __attribute__((ext_vector_type(4)));
typedef __bf16 bf16x2_t __attribute__((ext_vector_type(2)));
#define LDS_WAIT() asm volatile("s_waitcnt lgkmcnt(0)" ::: "memory")
__device__ __forceinline__ unsigned pk2(float lo, float hi) { f32x2 v = {lo, hi}; bf16x2_t b = __builtin_convertvector(v, bf16x2_t); return __builtin_bit_cast(unsigned, b); }
__device__ __forceinline__ v2u pk4(f32x4 v) { v2u r; r.x = pk2(v[0], v[1]); r.y = pk2(v[2], v[3]); return r; }
__device__ __forceinline__ f32x4 up4(v2u w) { f32x4 r; r[0] = __uint_as_float(w.x << 16); r[1] = __uint_as_float(w.x & 0xffff0000u); r[2] = __uint_as_float(w.y << 16); r[3] = __uint_as_float(w.y & 0xffff0000u); return r; }
typedef _Float16 h16x4 __attribute__((ext_vector_type(4)));
__device__ __forceinline__ v2u pk4h(f32x4 v) { const h16x4 h = __builtin_convertvector(v, h16x4); return __builtin_bit_cast(v2u, h); }
__device__ __forceinline__ f32x4 up4h(v2u w) { const h16x4 h = __builtin_bit_cast(h16x4, w); return __builtin_convertvector(h, f32x4); }
__device__ __forceinline__ void up8h(v4u w, f32x4& a, f32x4& b) { v2u lo; lo.x = w.x; lo.y = w.y; v2u hi; hi.x = w.z; hi.y = w.w; a = up4h(lo); b = up4h(hi); }
__device__ __forceinline__ v4u pk8(f32x4 a, f32x4 b) { const v2u x = pk4(a), y = pk4(b); v4u o; o.x = x.x; o.y = x.y; o.z = y.x; o.w = y.y; return o; }
__device__ __forceinline__ unsigned pk4f8(f32x4 a, float sc) {
    const float r0 = __builtin_amdgcn_fmed3f(a[0] * sc, -448.0f, 448.0f), r1 = __builtin_amdgcn_fmed3f(a[1] * sc, -448.0f, 448.0f), r2 = __builtin_amdgcn_fmed3f(a[2] * sc, -448.0f, 448.0f), r3 = __builtin_amdgcn_fmed3f(a[3] * sc, -448.0f, 448.0f);
    int p = __builtin_amdgcn_cvt_pk_fp8_f32(r0, r1, 0, false); p = __builtin_amdgcn_cvt_pk_fp8_f32(r2, r3, p, true); return (unsigned)p; }
__device__ __forceinline__ float wave_sum(float v) {
#pragma unroll
    for (int o = 1; o < 64; o <<= 1) v += __shfl_xor(v, o);
    return v;
}
__device__ __forceinline__ int bidx_of(int row) { return row < MP ? (row >> 12) : 2 + ((row - MP) >> 5); }
__device__ __forceinline__ int pos_of(int row) { return row < MP ? (row & (SEQ - 1)) : PAST + ((row - MP) & 31); }

#define XB_TMO      128
#define XB_XCNT(j)  (256  + 64 * (j))
#define XB_XSUB(j)  (1280 + 64 * (j))
#define XB_XGEN(j)  (2304 + 64 * (j))
#define XB_TOP      3328
#define XB_TOPGEN   3392
#define XCD_BAR_WORDS 3456
#define XB_SPIN_CAP (1u << 18)
__device__ __forceinline__ unsigned xb_ld(unsigned* p)              { return __hip_atomic_load(p, __ATOMIC_RELAXED, __HIP_MEMORY_SCOPE_AGENT); }
__device__ __forceinline__ unsigned xb_add(unsigned* p, unsigned v) { return __hip_atomic_fetch_add(p, v, __ATOMIC_RELAXED, __HIP_MEMORY_SCOPE_AGENT); }
__device__ __forceinline__ unsigned xb_xcc_id() { return (unsigned)__builtin_amdgcn_s_getreg((3 << 11) | 20) & 0xFu; }
#define XB_SPIN(cond, bar) do { unsigned _sp = 0; while (cond) { __builtin_amdgcn_s_sleep(1); \
    if ((++_sp & 255u) == 0u) { if (xb_ld(&(bar)[XB_TMO])) break; if (_sp > XB_SPIN_CAP) { atomicAdd(&(bar)[XB_TMO], 1u); break; } } } } while (0)
struct XcdBarrier { unsigned* bar; unsigned x; volatile LAS unsigned* st; };
__device__ __forceinline__ XcdBarrier xcd_barrier_post(unsigned* bar, volatile LAS unsigned* st) {
    XcdBarrier b; b.bar = bar; b.x = xb_xcc_id(); b.st = st;
    if (threadIdx.x == 0) (void)xb_add(&bar[XB_XCNT(b.x)], 1u);
    return b;
}
__device__ __forceinline__ void xcd_barrier_complete(unsigned* bar, unsigned x, unsigned& nloc, unsigned& nx) {
    const unsigned G = gridDim.x * gridDim.y * gridDim.z;
    unsigned sum, cnt, mine, sp = 0u;
    for (;;) {
        sum = 0u; cnt = 0u; mine = 0u;
#pragma unroll
        for (unsigned j = 0; j < 16; ++j) { const unsigned c = xb_ld(&bar[XB_XCNT(j)]); sum += c; cnt += (c > 0u) ? 1u : 0u; mine = (j == x) ? c : mine; }
        if (sum == G) break;
        __builtin_amdgcn_s_sleep(1);
        if ((++sp & 255u) == 0u) { if (xb_ld(&bar[XB_TMO])) break; if (sp > XB_SPIN_CAP) { atomicAdd(&bar[XB_TMO], 1u); break; } }
    }
    nloc = mine > 0u ? mine : 1u; nx = cnt > 0u ? cnt : 1u;
}
__device__ __forceinline__ void xcd_barrier(const XcdBarrier& b) {
    asm volatile("s_waitcnt vmcnt(0)" ::: "memory");
    __syncthreads();
    if (threadIdx.x == 0) {
        unsigned* bar = b.bar;
        __builtin_amdgcn_s_waitcnt(0);
        unsigned nloc = b.st[0], nx = b.st[1];
        if (nloc == 0u) { xcd_barrier_complete(bar, b.x, nloc, nx); b.st[0] = nloc; b.st[1] = nx; }
        const unsigned old = xb_add(&bar[XB_XSUB(b.x)], 1u);
        const unsigned gen = old / nloc;
        if (old + 1u == (gen + 1u) * nloc) {
            __builtin_amdgcn_fence(__ATOMIC_RELEASE, "agent");
            asm volatile("s_waitcnt vmcnt(0)" ::: "memory");
            const unsigned og = xb_add(&bar[XB_TOP], 1u);
            const unsigned tg = og / nx;
            if (og + 1u == (tg + 1u) * nx) xb_add(&bar[XB_TOPGEN], 1u);
            else XB_SPIN(xb_ld(&bar[XB_TOPGEN]) == tg, bar);
            __builtin_amdgcn_fence(__ATOMIC_ACQUIRE, "agent");
            xb_add(&bar[XB_XGEN(b.x)], 1u);
            asm volatile("s_waitcnt vmcnt(0)" ::: "memory");
        } else {
            XB_SPIN(xb_ld(&bar[XB_XGEN(b.x)]) == gen, bar);
            __builtin_amdgcn_fence(__ATOMIC_ACQUIRE, "agent");
            asm volatile("s_waitcnt vmcnt(0)" ::: "memory");
        }
    }
    __syncthreads();
}

namespace pg8 {
#define PG8_LAS __attribute__((address_space(3)))
typedef unsigned short bf16_t;
typedef int v4i_t __attribute__((ext_vector_type(4)));
typedef int v8i_t __attribute__((ext_vector_type(8)));
constexpr int BM = 256, BK = 64, HALF = 128, HTB = HALF * BK * 2, STAGE_BYTES = 8 * HTB, NXCD = 8, WGM = 8;
__host__ __device__ __forceinline__ int lds_byte(int r, int c) { const int st = (r >> 4) * 2 + (c >> 5), rr = r & 15, cc = c & 31, ob = rr * 64 + cc * 2; return st * 1024 + (ob ^ (((ob >> 9) & 1) << 5)); }
__host__ __device__ __forceinline__ void stage_rc(int b, int& R, int& C) { const int st = b / 1024, sb = b % 1024, swz = sb ^ (((sb >> 9) & 1) << 5); R = (st >> 1) * 16 + swz / 64; C = (st & 1) * 32 + (swz % 64) / 2; }
__host__ __device__ __forceinline__ int perm32(int rho) { const int n = rho >> 4, i = rho & 15; return 8 * (i >> 2) + 4 * n + (i & 3); }
template <bool B> struct BoolTag { static constexpr bool value = B; };
struct Unit { int pm, pn, kt0, nt, split; };
struct Gemm { const bf16_t* A; const bf16_t* Bt; int M, N, K; };
struct StaticOrder {
    int nM, nN, nwg, G, c, ntf;
    __host__ __device__ void init(int M, int N, int G_, int c_, int K_) { nM = M / BM; nN = N / BM; nwg = nM * nN; G = G_; c = c_; ntf = K_ / BK; }
    __host__ __device__ __forceinline__ void tile_of(int L, int& pm, int& pn) const {
        int wgid = L; { const int q = nwg / NXCD, r = nwg % NXCD, xcd = wgid % NXCD, off = wgid / NXCD; wgid = (xcd < r ? xcd * (q + 1) : r * (q + 1) + (xcd - r) * q) + off; }
        const int nig = WGM * nN, gid = wgid / nig, fm = gid * WGM, gsz = (nM - fm) < WGM ? (nM - fm) : WGM;
        pm = fm + ((wgid % nig) % gsz); pn = (wgid % nig) / gsz;
    }
    __host__ __device__ __forceinline__ bool next(int i, Unit& u) const {
        const long L = (long)i * G + c; if (L >= nwg) return false;
        tile_of((int)L, u.pm, u.pn); u.kt0 = 0; u.nt = ntf; u.split = -1; return true;
    }
    __device__ __forceinline__ void a_ready(const Unit&) const {}
    __device__ __forceinline__ void done(const Unit&) const {}
};
struct TailSplitOrder {
    StaticOrder so; int pmS;
    __host__ __device__ void init(int M, int N, int G_, int c_, int K_, int pmS_) { so.init(M, N, G_, c_, K_); pmS = pmS_; }
    __host__ __device__ __forceinline__ bool next(int i, Unit& u) const {
        Unit a; a.pm = 0; a.pn = 0; a.kt0 = 0; a.nt = so.ntf; a.split = -1;
        const bool fa = so.next(i, a);
        const long L = (long)i * so.G + so.c - so.nwg; const bool fb = !fa && L >= 0 && L < 256;
        const int sp = (int)(L & 15), small = 2 * (so.ntf / 32), nb = (so.ntf - 16 * small) / 2;
        const int nt2 = sp < nb ? small + 2 : small, kt2 = sp < nb ? sp * (small + 2) : nb * (small + 2) + (sp - nb) * small;
        u.pm = fa ? a.pm : pmS; u.pn = fa ? a.pn : (int)(L >> 4); u.kt0 = fa ? 0 : kt2; u.nt = fa ? so.ntf : nt2; u.split = fa ? -1 : sp;
        return fa || fb;
    }
    __device__ __forceinline__ void a_ready(const Unit&) const {}
    __device__ __forceinline__ void done(const Unit&) const {}
};
template <class Epi, class Sched, bool ALIGN_EPI = false, bool SP2 = false>
__device__ __forceinline__ void gemm_phase(PG8_LAS unsigned char* lds, const Gemm g, const Sched& S, const Epi& E) {
    const int tid = threadIdx.x, wid = __builtin_amdgcn_readfirstlane(tid >> 6), lane = tid & 63, wr = wid >> 2, wc = wid & 3, fr = lane & 15, fq = lane >> 4;
    const int K = g.K;
    unsigned voffA[2], voffB[2];
#pragma unroll
    for (int i = 0; i < 2; ++i) { int R, C; stage_rc(tid * 16 + i * 8192, R, C); const int Rb = Epi::PERM ? ((R & ~31) + perm32(R & 31)) : R;
        voffA[i] = (unsigned)(R * K + C) * 2u; voffB[i] = (unsigned)(Rb * K + C) * 2u; }
    const size_t kstep = (size_t)(BK * 2);
    const size_t hstep = (size_t)HALF * K * 2;
    const size_t tstep = 2 * hstep;
    const unsigned ldsw = (unsigned)wid * 1024u;
    const int aoff = lds_byte(wr * 64 + fr, fq * 8), boff = lds_byte(wc * 32 + fr, fq * 8);
#define PG8_SA(b, h) (((b) * 2 + (h)) * HTB)
#define PG8_SB(b, h) ((4 + (b) * 2 + (h)) * HTB)
#define PG8_STAGE(bufoff, gbase, voff) do { _Pragma("unroll") for (int _i = 0; _i < 2; ++_i) \
        __builtin_amdgcn_global_load_lds((const unsigned*)((const char*)(gbase) + (voff)[_i]), (PG8_LAS unsigned*)(lds + (bufoff) + ldsw + _i * 8192), 16, 0, 0); } while (0)
#define PG8_LDA(dst, b, h) do { if constexpr (F8) { _Pragma("unroll") for (int m = 0; m < 4; ++m) dst##8[m] = PG8_CAT8(*(const PG8_LAS bf16x8*)(lds + PG8_SA(b, h) + aoff + m * 2048), *(const PG8_LAS bf16x8*)(lds + PG8_SA(b, h) + aoff + m * 2048 + 1024)); } \
        else { _Pragma("unroll") for (int m = 0; m < 4; ++m) _Pragma("unroll") for (int k = 0; k < 2; ++k) dst[m][k] = *(const PG8_LAS bf16x8*)(lds + PG8_SA(b, h) + aoff + m * 2048 + k * 1024); } } while (0)
#define PG8_LDB(dst, b, h) do { if constexpr (F8) { _Pragma("unroll") for (int n = 0; n < 2; ++n) dst##8[n] = PG8_CAT8(*(const PG8_LAS bf16x8*)(lds + PG8_SB(b, h) + boff + n * 2048), *(const PG8_LAS bf16x8*)(lds + PG8_SB(b, h) + boff + n * 2048 + 1024)); } \
        else { _Pragma("unroll") for (int n = 0; n < 2; ++n) _Pragma("unroll") for (int k = 0; k < 2; ++k) dst[n][k] = *(const PG8_LAS bf16x8*)(lds + PG8_SB(b, h) + boff + n * 2048 + k * 1024); } } while (0)
#define PG8_CAT8(x, y) __builtin_shufflevector(__builtin_bit_cast(v4i_t, (x)), __builtin_bit_cast(v4i_t, (y)), 0, 1, 2, 3, 4, 5, 6, 7)
#define PG8_MMA(ai, bj, At, Bt) do { __builtin_amdgcn_s_setprio(1); \
        if constexpr (F8) { _Pragma("unroll") for (int m = 0; m < 4; ++m) _Pragma("unroll") for (int n = 0; n < 2; ++n) \
            asm volatile("v_mfma_f32_16x16x128_f8f6f4 %0, %1, %2, %0" : "+v"(acc[ai][bj][m][n]) : "v"(Bt##8[n]), "v"(At##8[m])); }     \
        else { _Pragma("unroll") for (int m = 0; m < 4; ++m) _Pragma("unroll") for (int n = 0; n < 2; ++n) _Pragma("unroll") for (int k = 0; k < 2; ++k) \
            acc[ai][bj][m][n] = __builtin_amdgcn_mfma_f32_16x16x32_bf16(Bt[n][k], At[m][k], acc[ai][bj][m][n], 0, 0, 0); } \
        __builtin_amdgcn_s_setprio(0); } while (0)
#define PG8_WAIT_V(n) asm volatile("s_waitcnt vmcnt(" #n ")" ::: "memory")
#define PG8_WAIT_L(n) asm volatile("s_waitcnt lgkmcnt(" #n ")" ::: "memory")
#define PG8_BAR __builtin_amdgcn_s_barrier()
#define PG8_SCHED __builtin_amdgcn_sched_barrier(0)
    Unit cur, nxt; int ui = 0;
    if (!S.next(0, cur)) return;
    f32x4 acc[2][2][4][2];
#pragma unroll
    for (int a = 0; a < 2; ++a)
#pragma unroll
        for (int b = 0; b < 2; ++b)
#pragma unroll
            for (int m = 0; m < 4; ++m)
#pragma unroll
                for (int n = 0; n < 2; ++n) acc[a][b][m][n] = (f32x4){0.f, 0.f, 0.f, 0.f};
    bf16x8 At[4][2], B0[2][2], B1[2][2]; v8i_t At8[4], B08[2], B18[2];
    const char* cA = (const char*)g.A + (size_t)cur.pm * tstep + (size_t)cur.kt0 * kstep; const char* cB = (const char*)g.Bt + (size_t)cur.pn * tstep + (size_t)cur.kt0 * kstep;
    S.a_ready(cur);
    if constexpr (SP2) {
        PG8_STAGE(PG8_SB(0, 0), cB, voffB); PG8_STAGE(PG8_SB(0, 1), cB + hstep, voffB); PG8_STAGE(PG8_SA(0, 0), cA, voffA); PG8_STAGE(PG8_SA(0, 1), cA + hstep, voffA);
        if (wr == 1) PG8_BAR;
        PG8_WAIT_V(2); PG8_BAR;
        PG8_STAGE(PG8_SB(1, 0), cB + kstep, voffB); PG8_STAGE(PG8_SA(1, 0), cA + kstep, voffA); PG8_STAGE(PG8_SB(1, 1), cB + hstep + kstep, voffB);
        PG8_WAIT_V(6); PG8_BAR;
    } else {
        PG8_STAGE(PG8_SB(0, 0), cB, voffB); PG8_STAGE(PG8_SA(0, 0), cA, voffA); PG8_STAGE(PG8_SB(0, 1), cB + hstep, voffB); PG8_STAGE(PG8_SA(0, 1), cA + hstep, voffA);
        if (wr == 1) PG8_BAR;
        PG8_WAIT_V(4); PG8_BAR;
        PG8_STAGE(PG8_SB(1, 0), cB + kstep, voffB); PG8_STAGE(PG8_SA(1, 0), cA + kstep, voffA); PG8_STAGE(PG8_SB(1, 1), cB + hstep + kstep, voffB);
        PG8_WAIT_V(6); PG8_BAR;
    }
    for (;;) {
        const bool has_next = S.next(ui + 1, nxt);
        const char* nA = has_next ? (const char*)g.A + (size_t)nxt.pm * tstep + (size_t)nxt.kt0 * kstep : cA; const char* nB = has_next ? (const char*)g.Bt + (size_t)nxt.pn * tstep + (size_t)nxt.kt0 * kstep : cB;
        const int nt = cur.nt;
        auto kloop = [&](auto f8tag, const int t0, const int t1) __attribute__((always_inline)) {
        constexpr bool F8 = decltype(f8tag)::value;
        for (int t = t0; t < t1; t += 2) {
            const bool last = (t == nt - 2);
            const char* a1 = cA + (size_t)(t + 1) * kstep;
            const char* a2 = last ? nA : cA + (size_t)(t + 2) * kstep; const char* b2 = last ? nB : cB + (size_t)(t + 2) * kstep;
            const char* a3 = a2 + kstep; const char* b3 = b2 + kstep;
            if (last && has_next) S.a_ready(nxt);
            if constexpr (SP2) {
            PG8_LDB(B0, 0, 0); PG8_LDB(B1, 0, 1); PG8_SCHED; PG8_LDA(At, 0, 0); PG8_STAGE(PG8_SA(1, 1), a1 + hstep, voffA);
            PG8_WAIT_V(8); PG8_WAIT_L(0); PG8_BAR; PG8_MMA(0, 0, At, B0); PG8_MMA(0, 1, At, B1); PG8_BAR; PG8_SCHED;
            PG8_LDA(At, 0, 1); PG8_STAGE(PG8_SB(0, 0), b2, voffB); PG8_STAGE(PG8_SB(0, 1), b2 + hstep, voffB); PG8_STAGE(PG8_SA(0, 0), a2, voffA);
            PG8_WAIT_V(8); PG8_WAIT_L(0); PG8_BAR; PG8_MMA(1, 0, At, B0); PG8_MMA(1, 1, At, B1); PG8_BAR; PG8_SCHED;
            PG8_LDB(B0, 1, 0); PG8_LDB(B1, 1, 1); PG8_SCHED; PG8_LDA(At, 1, 0); PG8_STAGE(PG8_SA(0, 1), a2 + hstep, voffA);
            PG8_WAIT_V(8); PG8_WAIT_L(0); PG8_BAR; PG8_MMA(0, 0, At, B0); PG8_MMA(0, 1, At, B1); PG8_BAR; PG8_SCHED;
            PG8_LDA(At, 1, 1); PG8_STAGE(PG8_SB(1, 0), b3, voffB); PG8_STAGE(PG8_SB(1, 1), b3 + hstep, voffB); PG8_STAGE(PG8_SA(1, 0), a3, voffA);
            PG8_WAIT_V(8); PG8_WAIT_L(0); PG8_BAR; PG8_MMA(1, 0, At, B0); PG8_MMA(1, 1, At, B1); PG8_BAR; PG8_SCHED;
            } else {
            PG8_LDB(B0, 0, 0); PG8_SCHED; PG8_LDA(At, 0, 0); PG8_STAGE(PG8_SA(1, 1), a1 + hstep, voffA);
            PG8_WAIT_L(8); PG8_BAR; PG8_WAIT_L(0); PG8_MMA(0, 0, At, B0); PG8_BAR; PG8_SCHED;
            PG8_LDB(B1, 0, 1); PG8_STAGE(PG8_SB(0, 0), b2, voffB);
            PG8_BAR; PG8_WAIT_L(0); PG8_MMA(0, 1, At, B1); PG8_BAR;
            PG8_LDA(At, 0, 1); PG8_STAGE(PG8_SA(0, 0), a2, voffA);
            PG8_BAR; PG8_WAIT_L(0); PG8_MMA(1, 0, At, B0); PG8_BAR; PG8_SCHED;
            PG8_STAGE(PG8_SB(0, 1), b2 + hstep, voffB);
            PG8_WAIT_V(6); PG8_BAR; PG8_MMA(1, 1, At, B1); PG8_BAR;
            PG8_LDB(B0, 1, 0); PG8_SCHED; PG8_LDA(At, 1, 0); PG8_STAGE(PG8_SA(0, 1), a2 + hstep, voffA);
            PG8_WAIT_L(8); PG8_BAR; PG8_WAIT_L(0); PG8_MMA(0, 0, At, B0); PG8_BAR; PG8_SCHED;
            PG8_LDB(B1, 1, 1); PG8_STAGE(PG8_SB(1, 0), b3, voffB);
            PG8_BAR; PG8_WAIT_L(0); PG8_MMA(0, 1, At, B1); PG8_BAR;
            PG8_LDA(At, 1, 1); PG8_STAGE(PG8_SA(1, 0), a3, voffA);
            PG8_BAR; PG8_WAIT_L(0); PG8_MMA(1, 0, At, B0); PG8_BAR; PG8_SCHED;
            PG8_STAGE(PG8_SB(1, 1), b3 + hstep, voffB);
            PG8_WAIT_V(6); PG8_BAR; PG8_MMA(1, 1, At, B1); PG8_BAR;
            }
        } };
        if constexpr (Epi::MIXNT16 > 0) {
            kloop(BoolTag<false>{}, 0, Epi::MIXNT16);
#pragma unroll
            for (int a = 0; a < 2; ++a)
#pragma unroll
                for (int b = 0; b < 2; ++b)
#pragma unroll
                    for (int m = 0; m < 4; ++m)
#pragma unroll
                        for (int n = 0; n < 2; ++n) acc[a][b][m][n] *= Epi::MIXSCALE;
            PG8_SCHED;
            kloop(BoolTag<true>{}, Epi::MIXNT16, nt);
        } else kloop(BoolTag<Epi::FP8>{}, 0, nt);
        if constexpr (Epi::FP8 || Epi::MIXNT16 > 0) asm volatile("s_nop 15\n\ts_nop 15" ::: "memory");
        if constexpr (ALIGN_EPI) { if (wr == 0) PG8_BAR; }
        E(acc, cur, wr, wc, fr, fq); S.done(cur);
        if (!has_next) break;
#pragma unroll
        for (int a = 0; a < 2; ++a)
#pragma unroll
            for (int b = 0; b < 2; ++b)
#pragma unroll
                for (int m = 0; m < 4; ++m)
#pragma unroll
                    for (int n = 0; n < 2; ++n) acc[a][b][m][n] = (f32x4){0.f, 0.f, 0.f, 0.f};
        cur = nxt; cA = nA; cB = nB; ++ui;
        if constexpr (ALIGN_EPI) { if (wr == 1) PG8_BAR; }
    }
    PG8_WAIT_V(0);
    if constexpr (!ALIGN_EPI) { if (wr == 0) PG8_BAR; }
    PG8_BAR;
#undef PG8_SA
#undef PG8_SB
#undef PG8_STAGE
#undef PG8_LDA
#undef PG8_LDB
#undef PG8_MMA
#undef PG8_CAT8
#undef PG8_WAIT_V
#undef PG8_WAIT_L
#undef PG8_BAR
#undef PG8_SCHED
}
}
#define PG8_SP2 true
#define PG8_ALIGN true

constexpr int NWAVES = 8;
constexpr int RING_OFF = 0, RING_BYTES = 131072;
constexpr int LDSCTL_OFF = RING_BYTES, MISC_OFF = LDSCTL_OFF + 320;
constexpr int LDS_BYTES = 147456;

struct Args { const float* in[25]; float* out; unsigned char* ws; int ph_lo, ph_hi; };

struct Frame {
    LAS unsigned char* lds;
    volatile LAS unsigned* MISC;
    unsigned* ctl;
    int tid, lane, wave, G, gw, NGW;
    float* out; unsigned char* ws;
};
#define WSP(T, off) ((T*)(F.ws + (off)))

struct Epi1 {
    static constexpr bool FP8 = false; static constexpr int MIXNT16 = 0;
    static constexpr bool PERM = false;
    const float *g_q, *g_kv; unsigned char* ws; float* out;
    __device__ __forceinline__ void operator()(const f32x4 (&acc)[2][2][4][2], const pg8::Unit& u, int wr, int wc, int fr, int fq) const {
        const int pn = u.pn; const bool samp = (u.pm >= MP / 256);
        const int row0 = u.pm * 256 + wr * 64 + fr;
        const int cw = wc * 32 + 4 * fq;
        if (pn < 4) {
            bf16* A2A = (bf16*)(ws + WS_A2A); float* QSS = (float*)(ws + WS_QSS);
            f32x4 gv[2][2];
#pragma unroll
            for (int bj = 0; bj < 2; ++bj)
#pragma unroll
                for (int n = 0; n < 2; ++n) gv[bj][n] = *(const f32x4*)(g_q + pn * 256 + bj * 128 + n * 16 + cw);
#pragma unroll
            for (int ai = 0; ai < 2; ++ai)
#pragma unroll
                for (int m = 0; m < 4; ++m) {
                    const int row = row0 + ai * 128 + m * 16; float ss = 0.f;
#pragma unroll
                    for (int bj = 0; bj < 2; ++bj)
#pragma unroll
                        for (int n = 0; n < 2; ++n) { const f32x4 v = acc[ai][bj][m][n]; ss += (v[0] * v[0] + v[1] * v[1]) + (v[2] * v[2] + v[3] * v[3]);
                            *(v2u*)(A2A + (size_t)row * QLORA + pn * 256 + bj * 128 + n * 16 + cw) = pk4(v * gv[bj][n]); }
                    ss += __shfl_xor(ss, 16); ss += __shfl_xor(ss, 32);
                    if (fq == 0) QSS[row * 16 + pn * 4 + wc] = ss;
                }
        } else if (pn < 6) {
            bf16* LATA = (bf16*)(ws + WS_LATA); float* KVSS = (float*)(ws + WS_KVSS);
            const int ct = (pn - 4) * 256;
            f32x4 gv[2][2];
#pragma unroll
            for (int bj = 0; bj < 2; ++bj)
#pragma unroll
                for (int n = 0; n < 2; ++n) gv[bj][n] = *(const f32x4*)(g_kv + ct + bj * 128 + n * 16 + cw);
            float* of = out + (samp ? OUT_SLAT - (size_t)MP * KVLORA : OUT_PLAT);
#pragma unroll
            for (int ai = 0; ai < 2; ++ai)
#pragma unroll
                for (int m = 0; m < 4; ++m) {
                    const int row = row0 + ai * 128 + m * 16; float ss = 0.f;
#pragma unroll
                    for (int bj = 0; bj < 2; ++bj)
#pragma unroll
                        for (int n = 0; n < 2; ++n) { const f32x4 v = acc[ai][bj][m][n]; ss += (v[0] * v[0] + v[1] * v[1]) + (v[2] * v[2] + v[3] * v[3]);
                            const int col = ct + bj * 128 + n * 16 + cw;
                            *(f32x4*)(of + (size_t)row * KVLORA + col) = v;
                            *(v2u*)(LATA + (size_t)row * KVLORA + col) = pk4(v * gv[bj][n]); }
                    ss += __shfl_xor(ss, 16); ss += __shfl_xor(ss, 32);
                    if (fq == 0) KVSS[row * 8 + (pn - 4) * 4 + wc] = ss;
                }
        } else if (pn < 14) {
            bf16* SBQ = (bf16*)(ws + WS_SBQ);
            const int ct = (pn - 6) * 256;
#pragma unroll
            for (int ai = 0; ai < 2; ++ai)
#pragma unroll
                for (int m = 0; m < 4; ++m) {
                    const int row = row0 + ai * 128 + m * 16;
#pragma unroll
                    for (int bj = 0; bj < 2; ++bj)
#pragma unroll
                        for (int n = 0; n < 2; ++n) *(v2u*)(SBQ + (size_t)row * 2048 + ct + bj * 128 + n * 16 + cw) = pk4(acc[ai][bj][m][n] * SB_QS);
                }
        } else if (pn < 30) {
            const bool isk = pn < 22; const int ct = (pn - (isk ? 14 : 22)) * 256;
            bf16* ob = (bf16*)(ws + (isk ? WS_SBK : WS_SBV));
            float* of = out + (samp ? (isk ? OUT_SSBK : OUT_SSBV) - (size_t)MP * 2048 : (isk ? OUT_PSBK : OUT_PSBV));
#pragma unroll
            for (int ai = 0; ai < 2; ++ai)
#pragma unroll
                for (int m = 0; m < 4; ++m) {
                    const int row = row0 + ai * 128 + m * 16;
#pragma unroll
                    for (int bj = 0; bj < 2; ++bj)
#pragma unroll
                        for (int n = 0; n < 2; ++n) { const f32x4 v = acc[ai][bj][m][n]; const int col = ct + bj * 128 + n * 16 + cw;
                            __builtin_nontemporal_store(v, (f32x4*)(of + (size_t)row * 2048 + col));
                            *(v2u*)(ob + (size_t)row * 2048 + col) = pk4(v); }
                }
        } else {
            if (wc < 2) {
                const float* cosT = (const float*)(ws + WS_COS); const float* sinT = (const float*)(ws + WS_SIN); bf16* KR = (bf16*)(ws + WS_KR);
                const int i0 = 16 * wc + 4 * fq; float* of = out + (samp ? OUT_SKR - (size_t)MP * ROPE : OUT_PKR);
#pragma unroll
                for (int ai = 0; ai < 2; ++ai)
#pragma unroll
                    for (int m = 0; m < 4; ++m) {
                        const int row = row0 + ai * 128 + m * 16; const int pos = pos_of(row);
                        const f32x4 cs = *(const f32x4*)(cosT + pos * 32 + i0), sn = *(const f32x4*)(sinT + pos * 32 + i0);
                        const f32x4 x1 = acc[ai][0][m][0], x2 = acc[ai][0][m][1];
                        const f32x4 o1 = x1 * cs - x2 * sn, o2 = x2 * cs + x1 * sn;
                        *(f32x4*)(of + (size_t)row * ROPE + i0) = o1; *(f32x4*)(of + (size_t)row * ROPE + 32 + i0) = o2;
                        *(v2u*)(KR + (size_t)row * ROPE + i0) = pk4(o1); *(v2u*)(KR + (size_t)row * ROPE + 32 + i0) = pk4(o2);
                    }
            }
        }
    }
};
struct Epi2a {
    static constexpr bool FP8 = false; static constexpr int MIXNT16 = 0;
    static constexpr bool PERM = false;
    const float *QSS, *cosT, *sinT; bf16* QM;
    __device__ __forceinline__ void operator()(const f32x4 (&acc)[2][2][4][2], const pg8::Unit& u, int wr, int wc, int fr, int fq) const {
        const int pn = u.pn; const int row0 = u.pm * 256 + wr * 64 + fr; const int cw = wc * 32 + 4 * fq;
#pragma unroll
        for (int ai = 0; ai < 2; ++ai)
#pragma unroll
            for (int m = 0; m < 4; ++m) {
                const int row = row0 + ai * 128 + m * 16;
                float ss = 0.f; const f32x4* sp = (const f32x4*)(QSS + row * 16);
#pragma unroll
                for (int j = 0; j < 4; ++j) { const f32x4 t = sp[j]; ss += (t[0] + t[1]) + (t[2] + t[3]); }
                const float sc = (1.0f / sqrtf(ss * (1.0f / QLORA) + EPS)) * MLA_QS;
                if (pn < 8) {
#pragma unroll
                    for (int bj = 0; bj < 2; ++bj)
#pragma unroll
                        for (int n = 0; n < 2; ++n) { const int col = pn * 256 + bj * 128 + n * 16 + cw; const int head = col >> 7, d = col & 127;
                            *(v2u*)(QM + (size_t)row * 3072 + head * 192 + d) = pk4(acc[ai][bj][m][n] * sc); }
                } else {
                    const int pos = pos_of(row); const int i0 = 16 * (wc & 1) + 4 * fq;
                    const f32x4 cs = *(const f32x4*)(cosT + pos * 32 + i0), sn = *(const f32x4*)(sinT + pos * 32 + i0);
#pragma unroll
                    for (int bj = 0; bj < 2; ++bj) { const int head = 4 * (pn - 8) + 2 * bj + (wc >> 1);
                        const f32x4 x1 = acc[ai][bj][m][0] * sc, x2 = acc[ai][bj][m][1] * sc;
                        const f32x4 o1 = x1 * cs - x2 * sn, o2 = x2 * cs + x1 * sn;
                        *(v2u*)(QM + (size_t)row * 3072 + head * 192 + 128 + i0) = pk4(o1); *(v2u*)(QM + (size_t)row * 3072 + head * 192 + 160 + i0) = pk4(o2); }
                }
            }
    }
};
struct Epi2b {
    static constexpr bool FP8 = false; static constexpr int MIXNT16 = 0;
    static constexpr bool PERM = false;
    const float* KVSS; bf16* KV; int rbase;
    __device__ __forceinline__ void operator()(const f32x4 (&acc)[2][2][4][2], const pg8::Unit& u, int wr, int wc, int fr, int fq) const {
        const int row0 = rbase + u.pm * 256 + wr * 64 + fr; const int cw = u.pn * 256 + wc * 32 + 4 * fq;
#pragma unroll
        for (int ai = 0; ai < 2; ++ai)
#pragma unroll
            for (int m = 0; m < 4; ++m) {
                const int row = row0 + ai * 128 + m * 16; float sc = 1.0f;
                if (row < MT) { const f32x4* sp = (const f32x4*)(KVSS + row * 8); const f32x4 a = sp[0], b = sp[1];
                    sc = 1.0f / sqrtf(((a[0] + a[1]) + (a[2] + a[3]) + (b[0] + b[1]) + (b[2] + b[3])) * (1.0f / KVLORA) + EPS); }
#pragma unroll
                for (int bj = 0; bj < 2; ++bj)
#pragma unroll
                    for (int n = 0; n < 2; ++n) *(v2u*)(KV + (size_t)row * 4096 + cw + bj * 128 + n * 16) = pk4(acc[ai][bj][m][n] * sc);
            }
    }
};
template <bool F8, bool BASE16> struct EpiRes {
    static constexpr bool PERM = false, FP8 = F8; static constexpr int MIXNT16 = 0;
    const void* base_p; const float* gate; bf16* out; bf16* slab; float oscale;
    __device__ __forceinline__ void operator()(const f32x4 (&acc)[2][2][4][2], const pg8::Unit& u, int wr, int wc, int fr, int fq) const {
        const int row0 = u.pm * 256 + wr * 64 + fr; const int cw = u.pn * 256 + wc * 32 + 4 * fq;
        if (u.split >= 0) {
            bf16* sp = slab + (size_t)u.split * MS * DM + (size_t)(wr * 64 + fr) * DM + cw;
#pragma unroll
            for (int ai = 0; ai < 2; ++ai)
#pragma unroll
                for (int m = 0; m < 4; ++m)
#pragma unroll
                    for (int bj = 0; bj < 2; ++bj)
#pragma unroll
                        for (int n = 0; n < 2; ++n) *(v2u*)(sp + (size_t)(ai * 128 + m * 16) * DM + bj * 128 + n * 16) = pk4h(acc[ai][bj][m][n] * oscale);
            return;
        }
        const int b = u.pm >> 4;
#pragma unroll
        for (int ai = 0; ai < 2; ++ai)
#pragma unroll
            for (int m = 0; m < 4; ++m) {
                const int row = row0 + ai * 128 + m * 16;
#pragma unroll
                for (int bj = 0; bj < 2; ++bj)
#pragma unroll
                    for (int n = 0; n < 2; ++n) { const int col = cw + bj * 128 + n * 16;
                        const f32x4 gt = *(const f32x4*)(gate + (size_t)b * NMOD + col);
                        const f32x4 bs = BASE16 ? up4h(*(const v2u*)((const bf16*)base_p + (size_t)row * DM + col)) : *(const f32x4*)((const float*)base_p + (size_t)row * DM + col);
                        *(v2u*)(out + (size_t)row * DM + col) = pk4h(bs + gt * (acc[ai][bj][m][n] * oscale)); }
            }
    }
};
struct EpiGU {
    static constexpr bool FP8 = false; static constexpr int MIXNT16 = GU_NT16;
    static constexpr float MIXSCALE = H8_SCALE * WGU_SCALE;
    static constexpr bool PERM = true;
    unsigned char* ACT8; float* slab;
    __device__ __forceinline__ void operator()(const f32x4 (&acc)[2][2][4][2], const pg8::Unit& u, int wr, int wc, int fr, int fq) const {
        if (u.split >= 0) {
            float* sp = slab + (size_t)u.split * 65536 + (size_t)(wr * 64 + fr) * 256 + wc * 32 + 8 * fq;
#pragma unroll
            for (int ai = 0; ai < 2; ++ai)
#pragma unroll
                for (int m = 0; m < 4; ++m)
#pragma unroll
                    for (int bj = 0; bj < 2; ++bj)
#pragma unroll
                        for (int n = 0; n < 2; ++n) *(f32x4*)(sp + (size_t)(ai * 128 + m * 16) * 256 + bj * 128 + 4 * n) = acc[ai][bj][m][n];
            return;
        }
        const int row0 = u.pm * 256 + wr * 64 + fr; const int col = u.pn * 128 + wc * 32 + 8 * fq;
#pragma unroll
        for (int ai = 0; ai < 2; ++ai)
#pragma unroll
            for (int m = 0; m < 4; ++m) {
                const int row = row0 + ai * 128 + m * 16; v2u w;
#pragma unroll
                for (int n = 0; n < 2; ++n) { const f32x4 g = acc[ai][0][m][n], up = acc[ai][1][m][n]; f32x4 r;
#pragma unroll
                    for (int e = 0; e < 4; ++e) { const float a = g[e] * up[e] * __builtin_amdgcn_rcpf(1.0f + __builtin_amdgcn_exp2f(-g[e] * (LOG2E / MIXSCALE))) * (ACT_SCALE / (MIXSCALE * MIXSCALE)); r[e] = __builtin_amdgcn_fmed3f(a, -448.0f, 448.0f); }
                    int p = __builtin_amdgcn_cvt_pk_fp8_f32(r[0], r[1], 0, false); p = __builtin_amdgcn_cvt_pk_fp8_f32(r[2], r[3], p, true);
                    if (n == 0) w.x = (unsigned)p; else w.y = (unsigned)p; }
                *(v2u*)(ACT8 + (size_t)row * DFF + col) = w;
            }
    }
};

__device__ __forceinline__ void transpose_item(const float* W, int Nsrc, bf16* WT, int K, int k0, int dst_n0, int src_col, LAS float* scr, int lane) {
    const int kh = lane >> 5, c = lane & 31;
    {
        const unsigned off0 = ((unsigned)(k0 + kh) * (unsigned)Nsrc + (unsigned)(src_col >= 0 ? src_col : 0)) * 4u, step = 8u * (unsigned)Nsrc;
        float v[32];
#pragma unroll
        for (int i = 0; i < 32; ++i) v[i] = __builtin_nontemporal_load((const float*)((const char*)W + (off0 + (unsigned)i * step)));
#pragma unroll
        for (int i = 0; i < 32; ++i) scr[(2 * i + kh) * 33 + c] = src_col >= 0 ? v[i] : 0.f;
    }
    LDS_WAIT(); asm volatile("" ::: "memory");
    const int ch = lane & 7;
#pragma unroll
    for (int j = 0; j < 4; ++j) { const int n = (lane >> 3) + 8 * j; const LAS float* s = scr + (8 * ch) * 33 + n;
        v4u o; o.x = pk2(s[0 * 33], s[1 * 33]); o.y = pk2(s[2 * 33], s[3 * 33]); o.z = pk2(s[4 * 33], s[5 * 33]); o.w = pk2(s[6 * 33], s[7 * 33]);
        *(v4u*)(WT + (size_t)(dst_n0 + n) * K + k0 + 8 * ch) = o; }
    LDS_WAIT(); asm volatile("" ::: "memory");
}
__device__ __forceinline__ void transpose_item_fp8(const float* W, int Nsrc, unsigned char* WT8, int K, int k0, int dst_n0, int src_col, float scale, LAS float* scr, int lane) {
    const int kh = lane >> 5, c = lane & 31;
    {
        const unsigned off0 = ((unsigned)(k0 + kh) * (unsigned)Nsrc + (unsigned)src_col) * 4u, step = 8u * (unsigned)Nsrc;
        float v[32];
#pragma unroll
        for (int i = 0; i < 32; ++i) v[i] = __builtin_nontemporal_load((const float*)((const char*)W + (off0 + (unsigned)i * step)));
#pragma unroll
        for (int i = 0; i < 32; ++i) scr[(2 * i + kh) * 33 + c] = v[i];
    }
    LDS_WAIT(); asm volatile("" ::: "memory");
    const int n = lane & 31, hf = lane >> 5;
    const LAS float* s = scr + (32 * hf) * 33 + n;
#pragma unroll
    for (int q = 0; q < 2; ++q) { v4u o;
#pragma unroll
        for (int d = 0; d < 4; ++d) { float f[4];
#pragma unroll
            for (int e = 0; e < 4; ++e) f[e] = __builtin_amdgcn_fmed3f(s[(16 * q + 4 * d + e) * 33] * scale, -448.0f, 448.0f);
            int p = __builtin_amdgcn_cvt_pk_fp8_f32(f[0], f[1], 0, false); p = __builtin_amdgcn_cvt_pk_fp8_f32(f[2], f[3], p, true); o[d] = (unsigned)p; }
        *(v4u*)(WT8 + (size_t)(dst_n0 + n) * K + k0 + 32 * hf + 16 * q) = o; }
    LDS_WAIT(); asm volatile("" ::: "memory");
}
__device__ __forceinline__ int rope_dim_of(int v) { return 32 * ((v >> 4) & 1) + 16 * (v >> 5) + (v & 15); }

__device__ __forceinline__ void adaln_unit(Frame& F, const Args& A, int cb, int ks) {
    const float* w_ada = A.in[8]; const float* c_p = A.in[6]; const float* c_s = A.in[7];
    float* P = WSP(float, WS_ADAP);
    LAS float* sc = (LAS float*)(F.lds + RING_OFF);
    LAS float* red = (LAS float*)(F.lds + RING_OFF + 8192);
    const int col4 = F.tid & 255, rh = F.tid >> 8;
    __syncthreads();
    for (int idx = F.tid; idx < 1280; idx += 512) { const int b = idx >> 7, kl = idx & 127; const int k = 128 * ks + kl;
        const float c = b < 2 ? c_p[b * DM + k] : c_s[(b - 2) * DM + k]; sc[kl * 10 + b] = c / (1.0f + expf(-c)); }
    __syncthreads();
    f32x4 acc[10];
#pragma unroll
    for (int b = 0; b < 10; ++b) acc[b] = (f32x4){0.f, 0.f, 0.f, 0.f};
    const float* wp = w_ada + (size_t)(128 * ks + rh) * NMOD + cb * 1024 + 4 * col4;
    for (int i0 = 0; i0 < 64; i0 += 16) {
        f32x4 wv[16];
#pragma unroll
        for (int u2 = 0; u2 < 16; ++u2) wv[u2] = __builtin_nontemporal_load((const f32x4*)(wp + (size_t)(2 * (i0 + u2)) * NMOD));
        asm volatile("" ::: "memory");
#pragma unroll
        for (int u2 = 0; u2 < 16; ++u2) {
            const LAS f32x2* sp = (const LAS f32x2*)(sc + (2 * (i0 + u2) + rh) * 10);
#pragma unroll
            for (int b2 = 0; b2 < 5; ++b2) { const f32x2 s = sp[b2]; acc[2 * b2] += wv[u2] * s[0]; acc[2 * b2 + 1] += wv[u2] * s[1]; }
        }
    }
    if (rh == 1) {
#pragma unroll
        for (int b = 0; b < 10; ++b) *(LAS f32x4*)(red + b * 1024 + 4 * col4) = acc[b];
    }
    __syncthreads();
    if (rh == 0) {
#pragma unroll
        for (int b = 0; b < 10; ++b) *(f32x4*)(P + ((size_t)ks * 10 + b) * NMOD + cb * 1024 + 4 * col4) = acc[b] + *(const LAS f32x4*)(red + b * 1024 + 4 * col4);
    }
    __syncthreads();
}
__device__ __forceinline__ void adaln_reduce(Frame& F, const Args& A, int c_lo, int c_hi) {
    const float* P = WSP(float, WS_ADAP); const float* b_ada = A.in[9]; float* MOD = WSP(float, WS_MOD);
    const int w4 = (c_hi - c_lo) / 4;
    for (int idx = blockIdx.x * 512 + F.tid; idx < 10 * w4; idx += F.G * 512) { const int b = idx / w4, c = c_lo + 4 * (idx % w4);
        f32x4 a = *(const f32x4*)(b_ada + c);
#pragma unroll 8
        for (int ks = 0; ks < 32; ++ks) a += *(const f32x4*)(P + ((size_t)ks * 10 + b) * NMOD + c);
        *(f32x4*)(MOD + (size_t)b * NMOD + c) = a; }
}
constexpr int I_1 = (DM / 64) * (N1 / 32), I_UQ = (QLORA / 64) * (3072 / 32), I_UKV = (KVLORA / 64) * (4096 / 32), I_O = (DM / 64) * (DM / 32),
              I_GU = (DM / 64) * (NGU / 32), I_D = (DFF / 64) * (DM / 32);
constexpr int I_EARLY = I_1 + I_UQ + I_UKV, NITEMS = I_EARLY + I_O + I_GU + I_D;
__device__ __forceinline__ void transpose_one(Frame& F, const Args& A, int it, LAS float* scr) {
    const int c = F.lane & 31; int r = it;
    if (r < I_1) { const int nblk = N1 / 32, kb = r / nblk, nb = r % nblk; const int n = 32 * nb + c; int src;
        if (n < 1536) src = n; else if (n < 7680) src = n + 64; else { const int v = n - 7680; src = v < 64 ? 1536 + rope_dim_of(v) : -1; }
        transpose_item(A.in[12], INCOLS, WSP(bf16, WS_W1T), DM, 64 * kb, 32 * nb, src, scr, F.lane); return; } r -= I_1;
    if (r < I_UQ) { const int nblk = 3072 / 32, kb = r / nblk, nb = r % nblk; const int n = 32 * nb + c; int src;
        if (n < 2048) src = (n >> 7) * 192 + (n & 127); else { const int cc = n - 2048; src = (cc >> 6) * 192 + 128 + rope_dim_of(cc & 63); }
        transpose_item(A.in[15], 3072, WSP(bf16, WS_WUQT), QLORA, 64 * kb, 32 * nb, src, scr, F.lane); return; } r -= I_UQ;
    if (r < I_UKV) { const int nblk = 4096 / 32, kb = r / nblk, nb = r % nblk; const int n = 32 * nb + c;
        transpose_item(n < 2048 ? A.in[16] : A.in[17], 2048, WSP(bf16, WS_WUKVT), KVLORA, 64 * kb, 32 * nb, n & 2047, scr, F.lane); return; } r -= I_UKV;
    if (r < I_O) { const int nblk = DM / 32, kb = r / nblk, nb = r % nblk;
        transpose_item(A.in[20], DM, WSP(bf16, WS_WOUTT), DM, 64 * kb, 32 * nb, 32 * nb + c, scr, F.lane); return; } r -= I_O;
    if (r < I_GU) { const int nblk = NGU / 32, kb = r / nblk, nb = r % nblk; const int n = 32 * nb + c; const int pn = n >> 8, cc = n & 255;
        if (64 * kb >= GU_KB16) transpose_item_fp8(cc < 128 ? A.in[21] : A.in[22], DFF, WSP(unsigned char, WS_WGUT) + GU_KB16, 2 * DM, 64 * kb, 32 * nb, pn * 128 + (cc & 127), WGU_SCALE, scr, F.lane);
        else transpose_item(cc < 128 ? A.in[21] : A.in[22], DFF, WSP(bf16, WS_WGUT), DM, 64 * kb, 32 * nb, pn * 128 + (cc & 127), scr, F.lane);
        return; } r -= I_GU;
    { const int nblk = DM / 32, kb = r / nblk, nb = r % nblk;
        transpose_item_fp8(A.in[23], DM, WSP(unsigned char, WS_WDT), DFF, 64 * kb, 32 * nb, 32 * nb + c, WD_SCALE, scr, F.lane); }
}
constexpr int NBG_T = (NITEMS - I_EARLY) / 64, NBG_A = 16 * 32, NBG = NBG_T + NBG_A;
constexpr int NBG_D0 = (I_O + I_GU) / 64, NBG_D = I_D / 64, NBG_MAIN = NBG - NBG_D;
static_assert((I_O + I_GU) % 64 == 0 && I_D % 64 == 0, "background queues: whole units");
static_assert((NITEMS - I_EARLY) % 64 == 0, "background transposes: whole units");
__device__ __forceinline__ void background_unit(Frame& F, const Args& A, int g) {
    if (g < NBG_T) {
        LAS float* scr = (LAS float*)(F.lds + RING_OFF + F.wave * 16384);
#pragma unroll 1
        for (int j = 0; j < 8; ++j) transpose_one(F, A, I_EARLY + 64 * g + 8 * j + F.wave, scr);
    } else { const int u = g - NBG_T; adaln_unit(F, A, 8 + (u & 15), u >> 4); }
}
__device__ __forceinline__ void background_drain(Frame& F, const Args& A, int qword, int nunits = NBG_MAIN, int skip_at = NBG_D0, int skip_len = NBG_D) {
    volatile LAS int* slot = (volatile LAS int*)(F.lds + MISC_OFF + 64);
    unsigned* head = F.ctl + qword;
    for (;;) {
        __syncthreads();
        if (F.tid == 0) *slot = (int)__hip_atomic_fetch_add(head, 1u, __ATOMIC_RELAXED, __HIP_MEMORY_SCOPE_AGENT);
        __syncthreads();
        const int idx = *slot;
        if (idx >= nunits) break;
        background_unit(F, A, idx < skip_at ? idx : idx + skip_len);
    }
}

__device__ __forceinline__ void background_take(Frame& F, const Args& A, int qword, int n) {
    volatile LAS int* slot = (volatile LAS int*)(F.lds + MISC_OFF + 64);
    unsigned* head = F.ctl + qword;
#pragma unroll 1
    for (int k = 0; k < n; ++k) {
        __syncthreads();
        if (F.tid == 0) *slot = (int)__hip_atomic_fetch_add(head, 1u, __ATOMIC_RELAXED, __HIP_MEMORY_SCOPE_AGENT);
        __syncthreads();
        const int idx = *slot;
        if (idx >= NBG_MAIN) break;
        background_unit(F, A, idx < NBG_D0 ? idx : idx + NBG_D);
    }
    __syncthreads();
}

__device__ __forceinline__ void ph_prologue(Frame& F, const Args& A, int parts) {
    if (parts & 1) { for (int u = blockIdx.x; u < 8 * 32; u += F.G) adaln_unit(F, A, u & 7, u >> 3); }
    if (parts & 16) adaln_reduce(F, A, 0, 2 * DM);
    if (parts & 2) {
        float* cosT = WSP(float, WS_COS); float* sinT = WSP(float, WS_SIN);
        for (int idx = blockIdx.x * 512 + F.tid; idx < SEQ * 32; idx += F.G * 512) { const int pos = idx >> 5, i = idx & 31;
            const double inv = exp(-(double)i * (1.0 / 32.0) * 9.210340371976184); const double a = (double)pos * inv;
            cosT[idx] = (float)cos(a); sinT[idx] = (float)sin(a); }
    }
    if (parts & 4) {
        const float* cl = A.in[2]; const float* ck = A.in[3]; bf16* LATA = WSP(bf16, WS_LATA) + (size_t)MT * KVLORA; bf16* KR = WSP(bf16, WS_KR) + (size_t)MT * ROPE;
        for (size_t i = (size_t)blockIdx.x * 512 + F.tid; i < (size_t)MC * KVLORA / 4; i += (size_t)F.G * 512) *(v2u*)(LATA + 4 * i) = pk4(*(const f32x4*)(cl + 4 * i));
        for (size_t i = (size_t)blockIdx.x * 512 + F.tid; i < (size_t)MC * ROPE / 4; i += (size_t)F.G * 512) *(v2u*)(KR + 4 * i) = pk4(*(const f32x4*)(ck + 4 * i));
    }
    if (parts & 8) {
        LAS float* scr = (LAS float*)(F.lds + RING_OFF + F.wave * 16384);
        for (int it = F.gw; it < I_EARLY; it += F.NGW) transpose_one(F, A, it, scr);
    }
}

__device__ __forceinline__ float wg_sum8(Frame& F, float v) {
    volatile LAS float* part = (volatile LAS float*)(F.lds + MISC_OFF + 256);
    __syncthreads();
    if (F.lane == 0) part[F.wave] = v;
    __syncthreads();
    float t = 0.f;
#pragma unroll
    for (int w = 0; w < 8; ++w) t += part[w];
    return t;
}
template <bool XP16>
__device__ __forceinline__ void ph_modnorm(Frame& F, const void* xp, const float* xs, const float* g, int ch_shift, int ch_scale, bf16* outb, const bf16* slab, int ch_gate, bf16* x1s) {
    const float* MOD = WSP(float, WS_MOD);
    if (XP16) for (int row = F.gw; row < MP; row += F.NGW) {
        const int b = bidx_of(row);
        f32x4 v[16]; float ss = 0.f;
#pragma unroll
        for (int j = 0; j < 8; ++j) { const int col = 8 * F.lane + 512 * j;
            if (XP16) up8h(*(const v4u*)((const bf16*)xp + (size_t)row * XPITCH + col), v[2 * j], v[2 * j + 1]);
            else { v[2 * j] = *(const f32x4*)((const float*)xp + (size_t)row * DM + col); v[2 * j + 1] = *(const f32x4*)((const float*)xp + (size_t)row * DM + col + 4); } }
#pragma unroll
        for (int j = 0; j < 16; ++j) ss += (v[j][0] * v[j][0] + v[j][1] * v[j][1]) + (v[j][2] * v[j][2] + v[j][3] * v[j][3]);
        const float rstd = 1.0f / sqrtf(wave_sum(ss) * (1.0f / DM) + EPS);
        const float* shp = MOD + (size_t)b * NMOD + ch_shift * DM; const float* scp = MOD + (size_t)b * NMOD + ch_scale * DM;
#pragma unroll
        for (int j = 0; j < 8; ++j) { const int col = 8 * F.lane + 512 * j; f32x4 o[2];
#pragma unroll
            for (int q = 0; q < 2; ++q) { const f32x4 gg = *(const f32x4*)(g + col + 4 * q), sc = *(const f32x4*)(scp + col + 4 * q), sh = *(const f32x4*)(shp + col + 4 * q);
                o[q] = v[2 * j + q] * rstd * gg * (1.0f + sc) + sh; }
            if (col >= GU_KB16) { v2u w; w.x = pk4f8(o[0], H8_SCALE); w.y = pk4f8(o[1], H8_SCALE); *(v2u*)((unsigned char*)outb + (size_t)row * (2 * DM) + GU_KB16 + col) = w; }
            else *(v4u*)(outb + (size_t)row * DM + col) = pk8(o[0], o[1]); }
    }
    if (!XP16) for (int row = F.gw; row < MP; row += F.NGW) {
        const int b = bidx_of(row);
        f32x4 v[16]; float ss = 0.f;
#pragma unroll
        for (int j = 0; j < 16; ++j) v[j] = XP16 ? up4h(*(const v2u*)((const bf16*)xp + (size_t)row * DM + 4 * F.lane + 256 * j)) : *(const f32x4*)((const float*)xp + (size_t)row * DM + 4 * F.lane + 256 * j);
#pragma unroll
        for (int j = 0; j < 16; ++j) ss += (v[j][0] * v[j][0] + v[j][1] * v[j][1]) + (v[j][2] * v[j][2] + v[j][3] * v[j][3]);
        const float rstd = 1.0f / sqrtf(wave_sum(ss) * (1.0f / DM) + EPS);
        const float* shp = MOD + (size_t)b * NMOD + ch_shift * DM; const float* scp = MOD + (size_t)b * NMOD + ch_scale * DM;
#pragma unroll
        for (int j = 0; j < 16; ++j) { const int col = 4 * F.lane + 256 * j;
            const f32x4 gg = *(const f32x4*)(g + col), sc = *(const f32x4*)(scp + col), sh = *(const f32x4*)(shp + col);
            const f32x4 o = v[j] * rstd * gg * (1.0f + sc) + sh;
            *(v2u*)(outb + (size_t)row * DM + col) = pk4(o); }
    }
    for (int sr = blockIdx.x; sr < MS; sr += F.G) {
        const int row = MP + sr, b = bidx_of(row);
        f32x4 v[2]; float ss = 0.f;
#pragma unroll
        for (int j = 0; j < 2; ++j) { const int col = 512 * F.wave + 4 * F.lane + 256 * j; v[j] = *(const f32x4*)(xs + (size_t)sr * DM + col);
            if (slab != nullptr) { f32x4 a = (f32x4){0.f, 0.f, 0.f, 0.f};
#pragma unroll
                for (int sI = 0; sI < 16; ++sI) a += up4h(*(const v2u*)(slab + ((size_t)sI * MS + sr) * DM + col));
                v[j] += *(const f32x4*)(MOD + (size_t)b * NMOD + ch_gate * DM + col) * a;
                *(v2u*)(x1s + (size_t)sr * DM + col) = pk4h(v[j]); }
            ss += (v[j][0] * v[j][0] + v[j][1] * v[j][1]) + (v[j][2] * v[j][2] + v[j][3] * v[j][3]); }
        const float rstd = 1.0f / sqrtf(wg_sum8(F, wave_sum(ss)) * (1.0f / DM) + EPS);
        const float* shp = MOD + (size_t)b * NMOD + ch_shift * DM; const float* scp = MOD + (size_t)b * NMOD + ch_scale * DM;
#pragma unroll
        for (int j = 0; j < 2; ++j) { const int col = 512 * F.wave + 4 * F.lane + 256 * j;
            const f32x4 gg = *(const f32x4*)(g + col), sc = *(const f32x4*)(scp + col), sh = *(const f32x4*)(shp + col);
            const f32x4 o = v[j] * rstd * gg * (1.0f + sc) + sh;
            if (XP16 && col >= GU_KB16) *(unsigned*)((unsigned char*)outb + (size_t)row * (2 * DM) + GU_KB16 + col) = pk4f8(o, H8_SCALE);
            else *(v2u*)(outb + (size_t)row * DM + col) = pk4(o); }
    }
}

__device__ __forceinline__ void ph_latent_finalize(Frame& F, const Args& A) {
    const float* KVSS = WSP(float, WS_KVSS); const float* g = A.in[14];
    for (int row = F.gw; row < MT; row += F.NGW) {
        float* p = row < MP ? F.out + OUT_PLAT + (size_t)row * KVLORA : F.out + OUT_SLAT + (size_t)(row - MP) * KVLORA;
        const f32x4 a = *(const f32x4*)(KVSS + row * 8), b = *(const f32x4*)(KVSS + row * 8 + 4);
        const float rstd = 1.0f / sqrtf(((a[0] + a[1]) + (a[2] + a[3]) + (b[0] + b[1]) + (b[2] + b[3])) * (1.0f / KVLORA) + EPS);
#pragma unroll
        for (int j = 0; j < 2; ++j) { const int col = 4 * F.lane + 256 * j; f32x4 v = *(const f32x4*)(p + col); const f32x4 gg = *(const f32x4*)(g + col);
            *(f32x4*)(p + col) = v * rstd * gg; }
    }
}

__device__ __forceinline__ void ph_merge_norm(Frame& F, const Args& A) {
    const float* OSS = WSP(float, WS_OSS); bf16* O = WSP(bf16, WS_O); const float* gm = A.in[18]; const float* gs = A.in[19];
    for (int row = F.gw; row < MT; row += F.NGW) {
        float s0 = 0.f, s1 = 0.f;
#pragma unroll
        for (int j = 0; j < 4; ++j) { const f32x4 a = *(const f32x4*)(OSS + row * 32 + 4 * j), b = *(const f32x4*)(OSS + row * 32 + 16 + 4 * j); s0 += (a[0] + a[1]) + (a[2] + a[3]); s1 += (b[0] + b[1]) + (b[2] + b[3]); }
        const float r0 = 1.0f / sqrtf(s0 * (1.0f / 2048.0f) + EPS), r1 = 1.0f / sqrtf(s1 * (1.0f / 2048.0f) + EPS);
#pragma unroll
        for (int j = 0; j < 8; ++j) { const int col = 8 * F.lane + 512 * j; const float r = col < 2048 ? r0 : r1; const float* gp = col < 2048 ? gm + col : gs + (col - 2048);
            const v4u w = *(const v4u*)(O + (size_t)row * DM + col); const f32x4 g0 = *(const f32x4*)gp, g1 = *(const f32x4*)(gp + 4);
            f32x4 a, b; a[0] = __uint_as_float(w.x << 16); a[1] = __uint_as_float(w.x & 0xffff0000u); a[2] = __uint_as_float(w.y << 16); a[3] = __uint_as_float(w.y & 0xffff0000u);
            b[0] = __uint_as_float(w.z << 16); b[1] = __uint_as_float(w.z & 0xffff0000u); b[2] = __uint_as_float(w.w << 16); b[3] = __uint_as_float(w.w & 0xffff0000u);
            const v2u pa = pk4(a * r * g0), pb = pk4(b * r * g1); v4u o; o.x = pa.x; o.y = pa.y; o.z = pb.x; o.w = pb.y;
            *(v4u*)(O + (size_t)row * DM + col) = o; }
    }
}

__device__ __forceinline__ void ph_final_norm(Frame& F, const Args& A) {
    const float* g = A.in[24]; const float* MOD = WSP(float, WS_MOD); const bf16* slab = WSP(bf16, WS_SLAB); const bf16* X1 = WSP(bf16, WS_X1); const bf16* X2 = WSP(bf16, WS_X2);
    for (int row = F.gw; row < MP; row += F.NGW) {
        float* p = F.out + OUT_Y + (size_t)row * DM;
        f32x4 v[16]; float ss = 0.f;
#pragma unroll
        for (int j = 0; j < 16; ++j) v[j] = up4h(*(const v2u*)(X2 + (size_t)row * DM + 4 * F.lane + 256 * j));
#pragma unroll
        for (int j = 0; j < 16; ++j) ss += (v[j][0] * v[j][0] + v[j][1] * v[j][1]) + (v[j][2] * v[j][2] + v[j][3] * v[j][3]);
        const float rstd = 1.0f / sqrtf(wave_sum(ss) * (1.0f / DM) + EPS);
#pragma unroll
        for (int j = 0; j < 16; ++j) { const int col = 4 * F.lane + 256 * j; __builtin_nontemporal_store(v[j] * rstd * *(const f32x4*)(g + col), (f32x4*)(p + col)); }
    }
    for (int sr = blockIdx.x; sr < MS; sr += F.G) {
        const int row = MP + sr; float* p = F.out + OUT_Y + (size_t)row * DM;
        const float* gp = MOD + (size_t)bidx_of(row) * NMOD + 5 * DM;
        f32x4 v[2]; float ss = 0.f;
#pragma unroll
        for (int j = 0; j < 2; ++j) { const int col = 512 * F.wave + 4 * F.lane + 256 * j; f32x4 a = (f32x4){0.f, 0.f, 0.f, 0.f};
#pragma unroll
            for (int sI = 0; sI < 16; ++sI) a += up4h(*(const v2u*)(slab + ((size_t)sI * MS + sr) * DM + col));
            v[j] = up4h(*(const v2u*)(X1 + (size_t)row * DM + col)) + *(const f32x4*)(gp + col) * a;
            ss += (v[j][0] * v[j][0] + v[j][1] * v[j][1]) + (v[j][2] * v[j][2] + v[j][3] * v[j][3]); }
        const float rstd = 1.0f / sqrtf(wg_sum8(F, wave_sum(ss)) * (1.0f / DM) + EPS);
#pragma unroll
        for (int j = 0; j < 2; ++j) { const int col = 512 * F.wave + 4 * F.lane + 256 * j; __builtin_nontemporal_store(v[j] * rstd * *(const f32x4*)(g + col), (f32x4*)(p + col)); }
    }
}

__device__ __forceinline__ int crow(int i, int h) { return (i & 3) + 8 * (i >> 2) + 4 * h; }
__device__ __forceinline__ unsigned voff_b(unsigned row, unsigned ch) { return 256u * row + 16u * (ch ^ (((row & 3u) << 2) | ((row >> 2) & 3u))); }
__device__ __forceinline__ v4u cvt8(const float* p) { const f32x4 a = *(const f32x4*)p, b = *(const f32x4*)(p + 4); const v2u x = pk4(a), y = pk4(b); v4u o; o.x = x.x; o.y = x.y; o.z = y.x; o.w = y.y; return o; }

template <int MODE>
__device__ __forceinline__ void attn_unit(Frame& F, const float* csk, const float* csv, bool sample, int b, int h, int qb) {
    constexpr int DQK = MODE == 0 ? 192 : 128, NS = DQK / 16, KP = DQK * 2 + 16, KCH = DQK / 8, NKC = KCH / 8;
    constexpr int VP = 320;
    constexpr int LDS_K = 0, LDS_V = 64 * KP, BUFB = LDS_V + 64 * VP;
    LAS unsigned char* lds = F.lds + RING_OFF;
    volatile LAS int* flags = (volatile LAS int*)(F.lds + MISC_OFF + 128);
    const int lane = F.lane, wave = F.wave, tid = F.tid, l31 = lane & 31, hh = lane >> 5;
    const int qrow0 = sample ? MP + 32 * b : b * SEQ + 256 * qb;
    const int qpos0 = sample ? PAST : 256 * qb;
    const bool wact = sample ? (wave == 0) : true;
    const int qrow = qrow0 + 32 * wave + l31, qpos = qpos0 + 32 * wave + l31;
    const bf16* KVb = WSP(bf16, WS_KV); const bf16* KRb = WSP(bf16, WS_KR);
    const bf16* SBKb = WSP(bf16, WS_SBK); const bf16* SBVb = WSP(bf16, WS_SBV);
    bf16x8 qf[NS];
    if (wact) {
        const bf16* qp = MODE == 0 ? WSP(bf16, WS_QM) + (size_t)qrow * 3072 + h * 192 + 8 * hh : WSP(bf16, WS_SBQ) + (size_t)qrow * 2048 + h * 128 + 8 * hh;
#pragma unroll
        for (int s = 0; s < NS; ++s) qf[s] = *(const bf16x8*)(qp + 16 * s);
    } else {
#pragma unroll
        for (int s = 0; s < NS; ++s) qf[s] = (bf16x8){0, 0, 0, 0, 0, 0, 0, 0};
    }
    f32x16 o[4];
#pragma unroll
    for (int c = 0; c < 4; ++c)
#pragma unroll
        for (int i = 0; i < 16; ++i) o[c][i] = 0.f;
    float mrun = -INFINITY, lrun = 0.f, prun = 1.0f;
    bool started = false, started0 = false, wdone = false;
    const int nblk = sample ? 33 : 4 * qb + 4;
    const unsigned tq = (lane & 15) >> 2, tp = lane & 3, tblk = (lane >> 4) & 1;
#define BLK_J(it) (MODE == 0 ? (it) : nblk - 1 - (it))
#define BLK_NEW(j) (sample && (j) == 32)
#define BLK_ROW(j) (sample ? (BLK_NEW(j) ? MP + 32 * b : MT + b * PAST + 64 * (j)) : b * SEQ + 64 * (j))
#define BLK_F32(j) (MODE == 1 && sample && !BLK_NEW(j))
    v4u pk[NKC], pv[2];
    const int r0 = tid >> 4, chv = tid & 15, rr = tid >> 3, chr = tid & 7;
    constexpr unsigned SRCP = MODE == 0 ? 8192u : 4096u;
    const unsigned goff = (unsigned)r0 * SRCP + 16u * chv + (unsigned)h * 256u;
    const unsigned lk0 = (unsigned)r0 * KP + 16u * chv, lv0 = (unsigned)r0 * VP + 16u * chv, lkr = (unsigned)rr * KP + 256u + 16u * chr;
#define ISSUE(j) do { if (!BLK_F32(j)) { const int krow_ = BLK_ROW(j); \
        const char* kb_ = (const char*)(MODE == 0 ? KVb : SBKb) + (size_t)krow_ * SRCP; const char* vb_ = MODE == 0 ? kb_ + 4096 : (const char*)SBVb + (size_t)krow_ * SRCP; \
        pk[0] = *(const v4u*)(kb_ + goff); pk[1] = *(const v4u*)(kb_ + goff + 32u * SRCP); \
        if (MODE == 0) pk[NKC - 1] = *(const v4u*)((const char*)KRb + (size_t)krow_ * 128 + rr * 128 + 16 * chr); \
        pv[0] = *(const v4u*)(vb_ + goff); pv[1] = *(const v4u*)(vb_ + goff + 32u * SRCP); } } while (0)
#define WRITE(j, bufo) do { const bool half_ = BLK_NEW(j); \
        if (BLK_F32(j)) { const size_t fo_ = ((size_t)(b * PAST + 64 * (j)) * NH + h) * SBD + (size_t)r0 * (NH * SBD) + 8 * chv; \
            pk[0] = cvt8(csk + fo_); pk[1] = cvt8(csk + fo_ + 32 * NH * SBD); pv[0] = cvt8(csv + fo_); pv[1] = cvt8(csv + fo_ + 32 * NH * SBD); } \
        const v4u z_ = (v4u){0u, 0u, 0u, 0u}; \
        *(LAS v4u*)(lds + (bufo) + LDS_K + lk0) = pk[0]; *(LAS v4u*)(lds + (bufo) + LDS_K + lk0 + 32 * KP) = half_ ? z_ : pk[1]; \
        if (MODE == 0) *(LAS v4u*)(lds + (bufo) + LDS_K + lkr) = (half_ && rr >= 32) ? z_ : pk[NKC - 1]; \
        *(LAS v4u*)(lds + (bufo) + LDS_V + lv0) = pv[0]; *(LAS v4u*)(lds + (bufo) + LDS_V + lv0 + 32 * VP) = half_ ? z_ : pv[1]; } while (0)
#pragma unroll
    for (int i = 0; i < NKC; ++i) pk[i] = (v4u){0u, 0u, 0u, 0u};
    pv[0] = (v4u){0u, 0u, 0u, 0u}; pv[1] = (v4u){0u, 0u, 0u, 0u};
    ISSUE(BLK_J(0));
    int bufo = 0;
    for (int it = 0; it < nblk; ++it) {
        const int j = BLK_J(it);
        const int kpos0 = 64 * j, nvalid = BLK_NEW(j) ? 32 : 64;
        WRITE(j, bufo);
        if (it + 1 < nblk) { const int jn = BLK_J(it + 1); ISSUE(jn); }
        __syncthreads();
        if (MODE == 1 && it > 0) { const int f = flags[((it - 1) & 1) * 8 + (lane & 7)]; if (__all(f != 0)) break; }
        bool need;
        if (MODE == 0) need = wact && (sample || j <= ((256 * qb + 32 * wave) >> 6));
        else need = wact && !wdone && (kpos0 < qpos0 + 32 * wave + 31);
        if (need) {
            started = true;
            LAS unsigned char* kb = lds + bufo + LDS_K; LAS unsigned char* vb = lds + bufo + LDS_V;
            bf16x8 pf[4];
            if (MODE == 0) {
                const LAS unsigned char* vl = vb + (4 * hh + tq) * VP + 32 * tblk + 8 * tp;
                const bool two = nvalid > 32;
                f32x16 s0, s1; const float nref = started0 ? -mrun : 0.f;
#pragma unroll
                for (int i = 0; i < 16; ++i) { s0[i] = nref; s1[i] = nref; }
                {
                    constexpr int PF = 3, NF = 2 * NS;
                    const int nf = two ? NF : NS;
                    bf16x8 kq[PF];
#define KFRAG(f) (*(const LAS bf16x8*)(kb + (((f) >= NS ? 32 : 0) + l31) * KP + 32 * ((f) >= NS ? (f) - NS : (f)) + 16 * hh))
#pragma unroll
                    for (int f = 0; f < PF; ++f) kq[f] = KFRAG(f);
                    __builtin_amdgcn_sched_barrier(0);
#pragma unroll
                    for (int f = 0; f < NF; ++f) {
                        if (f < NS || two) {
                            const bf16x8 kc = kq[f % PF];
                            if (f + PF < NF && (f + PF < NS || two)) kq[f % PF] = KFRAG(f + PF);
                            if (f < NS) s0 = __builtin_amdgcn_mfma_f32_32x32x16_bf16(kc, qf[f], s0, 0, 0, 0);
                            else s1 = __builtin_amdgcn_mfma_f32_32x32x16_bf16(kc, qf[f - NS], s1, 0, 0, 0);
                            __builtin_amdgcn_sched_barrier(0);
                        }
                    }
#undef KFRAG
                    (void)nf;
                }
                __builtin_amdgcn_sched_barrier(0);
#define MLA_HALF(SV, KS0, FIX_OTHER) do { \
                    float mx_ = SV[0]; \
                    _Pragma("unroll") for (int i = 1; i < 16; ++i) mx_ = fmaxf(mx_, SV[i]); \
                    mx_ = fmaxf(mx_, __shfl_xor(mx_, 32)); \
                    if (__any(!started0 || mx_ > 8.0f)) {     \
                        const float dl_ = started0 ? fmaxf(mx_, 0.f) : mx_; const float alpha_ = started0 ? __builtin_amdgcn_exp2f(-dl_) : 0.f; \
                        mrun = started0 ? mrun + dl_ : dl_; lrun *= alpha_; \
                        _Pragma("unroll") for (int i = 0; i < 16; ++i) SV[i] -= dl_; \
                        if (FIX_OTHER) { _Pragma("unroll") for (int i = 0; i < 16; ++i) s1[i] -= dl_; } \
                        _Pragma("unroll") for (int c = 0; c < 4; ++c) _Pragma("unroll") for (int i = 0; i < 16; ++i) o[c][i] *= alpha_; \
                    } \
                    started0 = true; \
                    float ps_ = 0.f; \
                    _Pragma("unroll") for (int i = 0; i < 16; ++i) { SV[i] = __builtin_amdgcn_exp2f(SV[i]); ps_ += SV[i]; } \
                    lrun += ps_; \
                    _Pragma("unroll") for (int s2 = 0; s2 < 2; ++s2) { const int r0_ = 8 * s2; v4u w; \
                        w.x = pk2(SV[r0_], SV[r0_ + 1]); w.y = pk2(SV[r0_ + 2], SV[r0_ + 3]); w.z = pk2(SV[r0_ + 4], SV[r0_ + 5]); w.w = pk2(SV[r0_ + 6], SV[r0_ + 7]); \
                        pf[(KS0) + s2] = __builtin_bit_cast(bf16x8, w); } \
                    {     \
                        s16x4 vlo_[3], vhi_[3]; \
                        _Pragma("unroll") for (int f = 0; f < 2; ++f) { const int ks = (KS0) + (f >> 2), c = f & 3; \
                            vlo_[f] = __builtin_bit_cast(s16x4, __builtin_amdgcn_ds_read_tr16_b64_v4i16((LAS s16x4*)(vl + (16 * ks) * VP + 64 * c))); \
                            vhi_[f] = __builtin_bit_cast(s16x4, __builtin_amdgcn_ds_read_tr16_b64_v4i16((LAS s16x4*)(vl + (16 * ks + 8) * VP + 64 * c))); } \
                        _Pragma("unroll") for (int f = 0; f < 8; ++f) { const int ks = (KS0) + (f >> 2), c = f & 3; \
                            if (f + 2 < 8) { const int ks2 = (KS0) + ((f + 2) >> 2), c2 = (f + 2) & 3; \
                                vlo_[(f + 2) % 3] = __builtin_bit_cast(s16x4, __builtin_amdgcn_ds_read_tr16_b64_v4i16((LAS s16x4*)(vl + (16 * ks2) * VP + 64 * c2))); \
                                vhi_[(f + 2) % 3] = __builtin_bit_cast(s16x4, __builtin_amdgcn_ds_read_tr16_b64_v4i16((LAS s16x4*)(vl + (16 * ks2 + 8) * VP + 64 * c2))); } \
                            const bf16x8 vf = __builtin_shufflevector(vlo_[f % 3], vhi_[f % 3], 0, 1, 2, 3, 4, 5, 6, 7); \
                            o[c] = __builtin_amdgcn_mfma_f32_32x32x16_bf16(vf, pf[ks], o[c], 0, 0, 0); } \
                        __builtin_amdgcn_sched_barrier(0); } } while (0)
                MLA_HALF(s0, 0, two);
                if (two) MLA_HALF(s1, 2, false);
#undef MLA_HALF
            } else {
#pragma unroll
                for (int tI = 1; tI >= 0; --tI) {
                    f32x16 sv;
#pragma unroll
                    for (int i = 0; i < 16; ++i) sv[i] = 0.f;
                    {
                        constexpr int PFK = 3; bf16x8 kq[PFK];
#define KFRAG1(f) (*(const LAS bf16x8*)(kb + (32 * tI + l31) * KP + 32 * (f) + 16 * hh))
#pragma unroll
                        for (int f = 0; f < PFK; ++f) kq[f] = KFRAG1(f);
                        __builtin_amdgcn_sched_barrier(0);
#pragma unroll
                        for (int f = 0; f < NS; ++f) { const bf16x8 kc = kq[f % PFK];
                            if (f + PFK < NS) kq[f % PFK] = KFRAG1(f + PFK);
                            sv = __builtin_amdgcn_mfma_f32_32x32x16_bf16(kc, qf[f], sv, 0, 0, 0);
                            __builtin_amdgcn_sched_barrier(0); }
#undef KFRAG1
                    }
                    float kp[16];
                    const int lim = min(qpos - kpos0, nvalid) - 32 * tI;
#pragma unroll
                    for (int i = 0; i < 16; ++i) { const bool ok = crow(i, hh) < lim;
                        const float z = __builtin_amdgcn_fmed3f(sv[i], -126.0f, 126.0f); const float e = __builtin_amdgcn_exp2f(-z); const float r = __builtin_amdgcn_rcpf(1.0f + e);
                        kp[i] = ok ? e * r : 1.0f; sv[i] = ok ? r : 0.f; }
                    float G[4], Go[4];
#pragma unroll
                    for (int g = 0; g < 4; ++g) { G[g] = (kp[4 * g] * kp[4 * g + 1]) * (kp[4 * g + 2] * kp[4 * g + 3]); Go[g] = __shfl_xor(G[g], 32); }
                    float later = prun;
#pragma unroll
                    for (int g = 3; g >= 0; --g) {
                        float tl = hh == 0 ? later * Go[g] : later;
#pragma unroll
                        for (int e = 3; e >= 0; --e) { const int i = 4 * g + e; sv[i] *= tl; tl *= kp[i]; }
                        later *= G[g] * Go[g];
                    }
                    prun = later;
#pragma unroll
                    for (int s2 = 0; s2 < 2; ++s2) { const int r0_ = 8 * s2; v4u w;
                        w.x = pk2(sv[r0_], sv[r0_ + 1]); w.y = pk2(sv[r0_ + 2], sv[r0_ + 3]); w.z = pk2(sv[r0_ + 4], sv[r0_ + 5]); w.w = pk2(sv[r0_ + 6], sv[r0_ + 7]);
                        pf[2 * tI + s2] = __builtin_bit_cast(bf16x8, w); }
                    __builtin_amdgcn_sched_barrier(0);
                }
            }
            if (MODE == 1) {
                const LAS unsigned char* vl = vb + (4 * hh + tq) * VP + 32 * tblk + 8 * tp;
                s16x4 vlo_[3], vhi_[3];
#define VFRAG1(f, slot) do { const int ks_ = (f) >> 2, c_ = (f) & 3; \
                    vlo_[slot] = __builtin_bit_cast(s16x4, __builtin_amdgcn_ds_read_tr16_b64_v4i16((LAS s16x4*)(vl + (16 * ks_) * VP + 64 * c_))); \
                    vhi_[slot] = __builtin_bit_cast(s16x4, __builtin_amdgcn_ds_read_tr16_b64_v4i16((LAS s16x4*)(vl + (16 * ks_ + 8) * VP + 64 * c_))); } while (0)
                VFRAG1(0, 0); VFRAG1(1, 1);
                __builtin_amdgcn_sched_barrier(0);
#pragma unroll
                for (int f = 0; f < 16; ++f) {
                    if (f + 2 < 16) VFRAG1(f + 2, (f + 2) % 3);
                    const bf16x8 vf = __builtin_shufflevector(vlo_[f % 3], vhi_[f % 3], 0, 1, 2, 3, 4, 5, 6, 7);
                    o[f & 3] = __builtin_amdgcn_mfma_f32_32x32x16_bf16(vf, pf[f >> 2], o[f & 3], 0, 0, 0);
                    __builtin_amdgcn_sched_barrier(0);
                }
#undef VFRAG1
            }
        }
        if (MODE == 1) {
            wdone = started && __all(prun < 1.1102230246251565e-16f);
            if (lane == 0) flags[(it & 1) * 8 + wave] = (!wact || wdone) ? 1 : 0;
        }
        bufo ^= BUFB;
    }
#undef BLK_J
#undef BLK_NEW
#undef BLK_ROW
#undef BLK_F32
#undef ISSUE
#undef WRITE
    if (wact) {
        float inv = 1.0f;
        if (MODE == 0) { const float lt = lrun + __shfl_xor(lrun, 32); inv = 1.0f / lt; }
        bf16* Ob = WSP(bf16, WS_O) + (size_t)qrow * DM + (MODE == 0 ? 0 : 2048) + h * 128;
        float ss = 0.f;
#pragma unroll
        for (int c = 0; c < 4; ++c)
#pragma unroll
            for (int g = 0; g < 4; ++g) { f32x4 v; v[0] = o[c][4 * g] * inv; v[1] = o[c][4 * g + 1] * inv; v[2] = o[c][4 * g + 2] * inv; v[3] = o[c][4 * g + 3] * inv;
                ss += (v[0] * v[0] + v[1] * v[1]) + (v[2] * v[2] + v[3] * v[3]);
                *(v2u*)(Ob + 32 * c + 8 * g + 4 * hh) = pk4(v); }
        ss += __shfl_xor(ss, 32);
        if (hh == 0) WSP(float, WS_OSS)[qrow * 32 + (MODE == 0 ? 0 : 16) + h] = ss;
    }
}

__device__ __forceinline__ void ph_attention(Frame& F, const Args& A, int qword, int mask) {
    const float* csk = A.in[4]; const float* csv = A.in[5];
    volatile LAS int* slot = (volatile LAS int*)(F.lds + MISC_OFF + 64);
    unsigned* head = F.ctl + qword;
    for (;;) {
        __syncthreads();
        if (F.tid == 0) *slot = (int)__hip_atomic_fetch_add(head, 1u, __ATOMIC_RELAXED, __HIP_MEMORY_SCOPE_AGENT);
        __syncthreads();
        const int id = *slot;
        if (id >= 1280) break;
        if (id < 128) { if (mask & 1) attn_unit<0>(F, csk, csv, true, id >> 4, id & 15, 0); }
        else if (id < 256) { const int bh = id - 128; if (mask & 2) attn_unit<1>(F, csk, csv, true, bh >> 4, bh & 15, 0); }
        else { const int pid = id - 256; const int qb = 15 - (pid >> 6), jj = pid & 63, bh = jj >> 1; if (jj & 1) { if (mask & 8) attn_unit<1>(F, csk, csv, false, bh >> 4, bh & 15, qb); } else { if (mask & 4) attn_unit<0>(F, csk, csv, false, bh >> 4, bh & 15, qb); } }
    }
}

constexpr int NPHASE = 11;
__global__ void __launch_bounds__(NWAVES * 64, 2) mk_fwd(Args args) {
    extern __shared__ __attribute__((aligned(16))) unsigned char lds[];
    Frame F;
    F.lds = (LAS unsigned char*)lds;
    F.MISC = (volatile LAS unsigned*)(F.lds + MISC_OFF);
    F.tid = threadIdx.x; F.lane = F.tid & 63; F.wave = __builtin_amdgcn_readfirstlane(F.tid >> 6);
    F.G = gridDim.x; F.gw = blockIdx.x * NWAVES + F.wave; F.NGW = F.G * NWAVES;
    F.ws = args.ws; F.ctl = (unsigned*)(args.ws + WS_CTL); F.out = args.out;
    for (int u = F.tid; u < (LDS_BYTES - LDSCTL_OFF) / 4; u += NWAVES * 64) ((LAS unsigned*)(F.lds + LDSCTL_OFF))[u] = 0u;
    __syncthreads();
    XcdBarrier bar; bar.bar = F.ctl + CW_BAR; bar.x = 0; bar.st = nullptr;
    const int lo = args.ph_lo, hi = args.ph_hi;
    bar = xcd_barrier_post(F.ctl + CW_BAR, F.MISC + 8);
#define IN(k) (lo <= (k) && (k) < hi)
#define SEAM(k) do { if (IN(k) && IN((k) + 1)) xcd_barrier(bar); } while (0)

#define DUP(k, ...) do { __VA_ARGS__ if (PROBE_DUP == (k)) { xcd_barrier(bar); __VA_ARGS__ } } while (0)
    if (IN(0)) { ph_prologue(F, args, 1); xcd_barrier(bar); ph_prologue(F, args, 2 | 4 | 8 | 16); if (PROBE_DUP >= 100 && PROBE_DUP < 132) { xcd_barrier(bar); ph_prologue(F, args, PROBE_DUP - 100); } } SEAM(0);
    if (IN(1)) { DUP(1, ph_modnorm<false>(F, args.in[0], args.in[1], args.in[10], 0, 1, WSP(bf16, WS_H), nullptr, 0, nullptr);); } SEAM(1);
    if (IN(2)) {
        DUP(20,
        {
            pg8::Gemm g{WSP(bf16, WS_H), WSP(bf16, WS_W1T), MT, N1, DM}; pg8::StaticOrder S; S.init(MT, N1, F.G, (int)blockIdx.x, DM);
            Epi1 E{args.in[13], args.in[14], F.ws, F.out};
            pg8::gemm_phase<Epi1, pg8::StaticOrder, PG8_ALIGN, PG8_SP2>(F.lds + RING_OFF, g, S, E);
        });
    } SEAM(2);
    if (IN(3)) {
        DUP(3,
        {
            pg8::Gemm g{WSP(bf16, WS_LATA), WSP(bf16, WS_WUKVT), MP, 4096, KVLORA}; pg8::StaticOrder S; S.init(MP, 4096, F.G, (int)blockIdx.x, KVLORA);
            Epi2b E{WSP(float, WS_KVSS), WSP(bf16, WS_KV), 0};
            pg8::gemm_phase<Epi2b, pg8::StaticOrder, PG8_ALIGN, PG8_SP2>(F.lds + RING_OFF, g, S, E);
        }
        {
            pg8::Gemm g{WSP(bf16, WS_A2A), WSP(bf16, WS_WUQT), MT, 3072, QLORA}; pg8::StaticOrder S; S.init(MT, 3072, F.G, (int)blockIdx.x, QLORA);
            Epi2a E{WSP(float, WS_QSS), WSP(float, WS_COS), WSP(float, WS_SIN), WSP(bf16, WS_QM)};
            pg8::gemm_phase<Epi2a, pg8::StaticOrder, PG8_ALIGN, PG8_SP2>(F.lds + RING_OFF, g, S, E);
        }
        {
            const int first_idle = ((MT / 256) * (3072 / 256)) % F.G; const int cs = (int)blockIdx.x >= first_idle ? (int)blockIdx.x - first_idle : (1 << 24);
            pg8::Gemm g{WSP(bf16, WS_LATA) + (size_t)MP * KVLORA, WSP(bf16, WS_WUKVT), MS, 4096, KVLORA}; pg8::StaticOrder S; S.init(MS, 4096, F.G, cs, KVLORA);
            Epi2b E{WSP(float, WS_KVSS), WSP(bf16, WS_KV), MP};
            pg8::gemm_phase<Epi2b, pg8::StaticOrder, PG8_ALIGN, PG8_SP2>(F.lds + RING_OFF, g, S, E);
        });
        DUP(21,
        {
            pg8::Gemm g{WSP(bf16, WS_LATA) + (size_t)MT * KVLORA, WSP(bf16, WS_WUKVT), MC, 4096, KVLORA}; pg8::StaticOrder S; S.init(MC, 4096, F.G, (int)blockIdx.x, KVLORA);
            Epi2b E{WSP(float, WS_KVSS), WSP(bf16, WS_KV), MT};
            pg8::gemm_phase<Epi2b, pg8::StaticOrder, PG8_ALIGN, PG8_SP2>(F.lds + RING_OFF, g, S, E);
        });
        {
            const int first_idle = ((MT / 256) * (3072 / 256)) % F.G;
            if ((int)blockIdx.x >= first_idle + (MS / 256) * 16) background_take(F, args, CW_QUEUE + 128, 1);
        }
        ph_latent_finalize(F, args);
    } SEAM(3);
    if (IN(4)) {
        if ((blockIdx.x & 3) == 1) background_drain(F, args, CW_QUEUE + 128);
        ph_attention(F, args, CW_QUEUE, 15);
        background_drain(F, args, CW_QUEUE + 128);
        if (PROBE_DUP >= 40 && PROBE_DUP < 56) { xcd_barrier(bar); ph_attention(F, args, CW_QUEUE + 64, PROBE_DUP - 40); }
        if (PROBE_DUP == 57) { xcd_barrier(bar); if (blockIdx.x & 1) background_drain(F, args, CW_QUEUE + 256); ph_attention(F, args, CW_QUEUE + 64, 15); background_drain(F, args, CW_QUEUE + 256); }
        if (PROBE_DUP == 58) { xcd_barrier(bar); background_drain(F, args, CW_QUEUE + 256); }
    } SEAM(4);
    if (IN(5)) { adaln_reduce(F, args, 2 * DM, NMOD); ph_merge_norm(F, args); } SEAM(5);
    if (IN(6)) {
        DUP(6,
        { pg8::Gemm g{WSP(bf16, WS_O), WSP(bf16, WS_WOUTT), MT, DM, DM}; pg8::TailSplitOrder S; S.init(MP, DM, F.G, (int)blockIdx.x, DM, MP / 256);
        EpiRes<false, false> E{args.in[0], WSP(float, WS_MOD) + 2 * DM, WSP(bf16, WS_X1), WSP(bf16, WS_SLAB), 1.0f};
        pg8::gemm_phase<EpiRes<false, false>, pg8::TailSplitOrder, PG8_ALIGN, PG8_SP2>(F.lds + RING_OFF, g, S, E); });
    } SEAM(6);
    if (IN(7)) { DUP(7, ph_modnorm<true>(F, WSP(bf16, WS_X1), args.in[1], args.in[11], 3, 4, WSP(bf16, WS_H), WSP(bf16, WS_SLAB), 2, WSP(bf16, WS_X1) + (size_t)MP * DM);); } SEAM(7);
    if (IN(8)) {
        DUP(8,
        { pg8::Gemm g{WSP(bf16, WS_H), WSP(bf16, WS_WGUT), MT, NGU, DM}; pg8::StaticOrder S; S.init(MT, NGU, F.G, (int)blockIdx.x, GU_NT * 64);
        EpiGU E{WSP(unsigned char, WS_ACT), WSP(float, WS_SLAB)};
        pg8::gemm_phase<EpiGU, pg8::StaticOrder, PG8_ALIGN, PG8_SP2>(F.lds + RING_OFF, g, S, E); });
        background_drain(F, args, CW_QUEUE + 384, NBG_D, 0, NBG_D0);
    } SEAM(8);
    if (IN(9)) {
        DUP(9,
        { pg8::Gemm g{WSP(bf16, WS_ACT), WSP(bf16, WS_WDT), MT, DM, DFF / 2}; pg8::TailSplitOrder S; S.init(MP, DM, F.G, (int)blockIdx.x, DFF / 2, MP / 256);
        EpiRes<true, true> E{WSP(bf16, WS_X1), WSP(float, WS_MOD) + 5 * DM, WSP(bf16, WS_X2), WSP(bf16, WS_SLAB), 1.0f / (ACT_SCALE * WD_SCALE)};
        pg8::gemm_phase<EpiRes<true, true>, pg8::TailSplitOrder, PG8_ALIGN, PG8_SP2>(F.lds + RING_OFF, g, S, E); });
    } SEAM(9);
    if (IN(10)) { ph_final_norm(F, args); }
#undef DUP
#undef IN
#undef SEAM
}

extern "C" void kernel_launch(void* const* d_in, const int* in_sizes, int n_in, void* d_out, int out_size, void* d_ws, size_t ws_size, hipStream_t stream) {
    static int grid = 0;
    if (grid == 0) {
        if (n_in != 25 || out_size != (int)OUT_TOTAL || ws_size < WS_END) { fprintf(stderr, "kernel_launch: unexpected sizes n_in %d out %d ws %zu\n", n_in, out_size, ws_size); grid = -1; return; }
        int dev = 0, cus = 0, per_cu = 0;
        if (hipGetDevice(&dev) != hipSuccess || hipDeviceGetAttribute(&cus, hipDeviceAttributeMultiprocessorCount, dev) != hipSuccess) { grid = -1; return; }
        if (hipFuncSetAttribute((const void*)mk_fwd, hipFuncAttributeMaxDynamicSharedMemorySize, LDS_BYTES) != hipSuccess) { fprintf(stderr, "kernel_launch: hipFuncSetAttribute failed\n"); grid = -1; return; }
        if (hipOccupancyMaxActiveBlocksPerMultiprocessor(&per_cu, (const void*)mk_fwd, NWAVES * 64, LDS_BYTES) != hipSuccess || per_cu < 1) { fprintf(stderr, "kernel_launch: occupancy query says %d\n", per_cu); }
        (void)hipGetLastError();
        grid = cus;
    }
    if (grid < 0) return;
    if (hipMemsetAsync((char*)d_ws + WS_CTL, 0, CTL_ZERO_BYTES, stream) != hipSuccess) return;
    Args a{};
    for (int i = 0; i < 25; ++i) a.in[i] = (const float*)d_in[i];
    a.out = (float*)d_out; a.ws = (unsigned char*)d_ws;
#if MK_ONE_LAUNCH
    a.ph_lo = 0; a.ph_hi = NPHASE;
    hipLaunchKernelGGL(mk_fwd, dim3(grid), dim3(NWAVES * 64), LDS_BYTES, stream, a);
#else
    for (int p = 0; p < NPHASE; ++p) { a.ph_lo = p; a.ph_hi = p + 1; hipLaunchKernelGGL(mk_fwd, dim3(grid), dim3(NWAVES * 64), LDS_BYTES, stream, a); }
#endif
}
```
